# Optimizing an MI355X kernel written in HIP

```python
import jax, jax.numpy as jnp
from jax import lax
import numpy as np

D_MODEL = 1024
BATCH = 16
SEQ = 2048
DEPTH = 4
DEC_BATCH = 32
DEC_SEQ = 64
PAST_LEN = 2048

CHUNK = 64
N_EVEN = (DEPTH + 1) // 2
N_ODD = DEPTH // 2
EPS = 1e-6
W_A = D_MODEL // 2
CONV_A_W = 3
HD_B = 64
W_B = D_MODEL // 2
H_B = W_B // HD_B
PAST_CHUNKS_B = 8
BAND_PAST = PAST_CHUNKS_B * CHUNK
BAND = BAND_PAST + CHUNK
REL_CLIP = 4 * CHUNK
HD_C = 128
H_C = D_MODEL // HD_C
W_C = H_C * HD_C
CONV_C_W = 4
IN_EVEN = 4 * W_A + 4 * W_B
IN_ODD = 4 * W_C + 2 * H_C

kernel_name = 'hybrid_streaming_conv_band_attn_gdn_step'


def rmsnorm(x, g):
    xf = x.astype(jnp.float32)
    y = xf * lax.rsqrt(jnp.mean(xf * xf, axis=-1, keepdims=True) + EPS)
    return (y * g.astype(jnp.float32)).astype(x.dtype)


def l2norm(x):
    return x * lax.rsqrt(jnp.sum(x * x, axis=-1, keepdims=True) + EPS)


def causal_dwconv(u, hist, w):
    width = w.shape[0]
    T = u.shape[1]
    up = jnp.concatenate([hist.astype(u.dtype), u], axis=1)
    out = up[:, 0:T] * w[0]
    for j in range(1, width):
        out = out + up[:, j:j + T] * w[j]
    return out, up[:, up.shape[1] - (width - 1):]


def rel_bias(table, q_pos, k_pos):
    idx = jnp.clip(q_pos[:, None] - k_pos[None, :], -REL_CLIP, REL_CLIP) + REL_CLIP
    return jnp.take(table, idx, axis=1).astype(jnp.float32)


def attend(q, k, v, bias, valid):
    s = jnp.einsum('bqhd,bkhd->bhqk', q, k, preferred_element_type=jnp.float32) * (HD_B ** -0.5) + bias[None]
    s = jnp.where(valid[None, None, None, :], s, -jnp.inf)
    p = jax.nn.softmax(s, axis=-1)
    return jnp.einsum('bhqk,bkhd->bqhd', p.astype(v.dtype), v)


def band_attn_prompt(q, k, v, table):
    Bn, T, H, Dh = q.shape
    nc = T // CHUNK
    pad = ((0, 0), (BAND_PAST, 0), (0, 0), (0, 0))
    kpad = jnp.pad(k, pad)
    vpad = jnp.pad(v, pad)
    qc = jnp.moveaxis(q.reshape(Bn, nc, CHUNK, H, Dh), 1, 0)
    k_off = jnp.arange(BAND) - BAND_PAST
    bias = rel_bias(table, jnp.arange(CHUNK), k_off)

    def one(args):
        qb, c = args
        start = c * CHUNK
        kb = lax.dynamic_slice_in_dim(kpad, start, BAND, axis=1)
        vb = lax.dynamic_slice_in_dim(vpad, start, BAND, axis=1)
        valid = (start + k_off) >= 0
        return attend(qb, kb, vb, bias, valid)

    o = lax.map(one, (qc, jnp.arange(nc)))
    o = jnp.moveaxis(o, 0, 1).reshape(Bn, T, H, Dh)
    keep = min(BAND_PAST, T)
    return o, k[:, T - keep:], v[:, T - keep:]


def band_attn_sample(q, k, v, ck, cv, table):
    T = q.shape[1]
    cb = ck.shape[1]
    kk = jnp.concatenate([ck.astype(k.dtype), k], axis=1)
    vv = jnp.concatenate([cv.astype(v.dtype), v], axis=1)
    bias = rel_bias(table, jnp.arange(T), jnp.arange(cb + T) - cb)
    valid = jnp.ones((cb + T,), dtype=bool)
    return attend(q, kk, vv, bias, valid)


def gdn_chunk(S, q, k, v, g, beta):
    L = q.shape[1]
    gc = jnp.cumsum(g, axis=1)
    gct = jnp.swapaxes(gc, 1, 2)
    incl = jnp.tril(jnp.ones((L, L), dtype=bool))
    strict = jnp.tril(jnp.ones((L, L), dtype=bool), -1)
    decay = jnp.exp(jnp.where(incl, gct[..., :, None] - gct[..., None, :], -jnp.inf))
    bt = jnp.swapaxes(beta, 1, 2)
    kk = jnp.einsum('blhd,bmhd->bhlm', k, k)
    a = jnp.where(strict, bt[..., :, None] * kk * decay, 0.0)
    tmat = a + jnp.eye(L, dtype=a.dtype)
    rhs = jnp.swapaxes(jnp.concatenate([v * beta[..., None], k * (beta * jnp.exp(gc))[..., None]], axis=-1), 1, 2)
    sol = lax.linalg.triangular_solve(tmat, rhs, left_side=True, lower=True, unit_diagonal=True)
    u = sol[..., :HD_C] - jnp.einsum('bhlk,bhkv->bhlv', sol[..., HD_C:], S)
    qk = jnp.einsum('blhd,bmhd->bhlm', q, k) * decay
    o = jnp.einsum('blhk,bhkv->blhv', q * jnp.exp(gc)[..., None], S) + jnp.einsum('bhlm,bhmv->blhv', qk, u)
    g_last = gc[:, -1]
    k_dec = k * jnp.exp(g_last[:, None, :] - gc)[..., None]
    S_new = jnp.exp(g_last)[..., None, None] * S + jnp.einsum('blhk,bhlv->bhkv', k_dec, u)
    return S_new, o


def gated_delta(q, k, v, g, beta, S0):
    Bn, T = q.shape[0], q.shape[1]
    if T <= CHUNK:
        return gdn_chunk(S0, q, k, v, g, beta)
    nc = T // CHUNK

    def split(t):
        return jnp.moveaxis(t.reshape((Bn, nc, CHUNK) + t.shape[2:]), 1, 0)

    def step(S, xs):
        return gdn_chunk(S, *xs)

    S, o = lax.scan(step, S0, (split(q), split(k), split(v), split(g), split(beta)))
    return S, jnp.moveaxis(o, 0, 1).reshape(Bn, T, H_C, HD_C)


def mixer_even(h, conv_hist, ck, cv, w_in, conv_w, table, w_out):
    Bn, T, _ = h.shape
    p = h @ w_in
    a_b, a_c, a_h, a_z, q, k, v, b_z = jnp.split(p, 8, axis=-1)
    conv_out, new_hist = causal_dwconv(a_c * a_h, conv_hist, conv_w)
    ya = a_b * conv_out * jax.nn.silu(a_z)
    q = q.reshape(Bn, T, H_B, HD_B)
    k = k.reshape(Bn, T, H_B, HD_B)
    v = v.reshape(Bn, T, H_B, HD_B)
    if ck is None:
        o, nk, nv = band_attn_prompt(q, k, v, table)
    else:
        o = band_attn_sample(q, k, v, ck, cv, table)
        nk, nv = k, v
    yb = o.reshape(Bn, T, W_B) * jax.nn.silu(b_z)
    y = jnp.concatenate([ya, yb], axis=-1) @ w_out
    return y, new_hist, nk, nv


def mixer_odd(h, conv_hist, S0, w_in, conv_w, a_log, dt_bias, onorm, w_out):
    Bn, T, _ = h.shape
    f32 = jnp.float32
    p = h @ w_in
    qkv, z, b_lg, a_lg = jnp.split(p, [3 * W_C, 4 * W_C, 4 * W_C + H_C], axis=-1)
    qkv, new_hist = causal_dwconv(qkv, conv_hist, conv_w)
    qkv = jax.nn.silu(qkv).astype(f32)
    q, k, v = [t.reshape(Bn, T, H_C, HD_C) for t in jnp.split(qkv, 3, axis=-1)]
    q = l2norm(q) * (HD_C ** -0.5)
    k = l2norm(k)
    beta = jax.nn.sigmoid(b_lg.astype(f32))
    g = -jnp.exp(a_log.astype(f32)) * jax.nn.softplus(a_lg.astype(f32) + dt_bias.astype(f32))
    S, o = gated_delta(q, k, v, g, beta, S0.astype(f32))
    o = rmsnorm(o, onorm).reshape(Bn, T, W_C).astype(h.dtype)
    y = (o * jax.nn.silu(z)) @ w_out
    return y, new_hist, S


def setup_inputs(seed: int = 0) -> dict:
    key = jax.random.key(seed)
    ks = jax.random.split(key, 20)
    cb = min(BAND_PAST, PAST_LEN)

    def nrm(k, shape, s):
        return jax.random.normal(k, shape, jnp.float32) * s

    dt = jnp.exp(jax.random.uniform(ks[18], (N_ODD, H_C), jnp.float32, np.log(1e-3), np.log(1e-1)))
    return {
        'x_prompt': nrm(ks[0], (BATCH, SEQ, D_MODEL), 1.0),
        'x_sample': nrm(ks[1], (DEC_BATCH, DEC_SEQ, D_MODEL), 1.0),
        'cache_conv_a': nrm(ks[2], (N_EVEN, DEC_BATCH, CONV_A_W - 1, W_A), 1.0),
        'cache_k_b': nrm(ks[3], (N_EVEN, DEC_BATCH, cb, H_B, HD_B), 1.0),
        'cache_v_b': nrm(ks[4], (N_EVEN, DEC_BATCH, cb, H_B, HD_B), 1.0),
        'state_conv_c': nrm(ks[5], (N_ODD, DEC_BATCH, CONV_C_W - 1, 3 * W_C), 1.0),
        'state_s_c': nrm(ks[6], (N_ODD, DEC_BATCH, H_C, HD_C, HD_C), 0.1),
        'norm_pre': 1.0 + nrm(ks[7], (DEPTH, D_MODEL), 0.1),
        'norm_post': 1.0 + nrm(ks[8], (DEPTH, D_MODEL), 0.1),
        'w_in_even': nrm(ks[9], (N_EVEN, D_MODEL, IN_EVEN), D_MODEL ** -0.5),
        'conv_w_a': nrm(ks[10], (N_EVEN, CONV_A_W, W_A), CONV_A_W ** -0.5),
        'rel_bias_b': nrm(ks[11], (N_EVEN, H_B, 2 * REL_CLIP + 1), 0.3),
        'w_out_even': nrm(ks[12], (N_EVEN, W_A + W_B, D_MODEL), (W_A + W_B) ** -0.5),
        'w_in_odd': nrm(ks[13], (N_ODD, D_MODEL, IN_ODD), D_MODEL ** -0.5),
        'conv_w_c': nrm(ks[14], (N_ODD, CONV_C_W, 3 * W_C), CONV_C_W ** -0.5),
        'a_log_c': jnp.log(jax.random.uniform(ks[15], (N_ODD, H_C), jnp.float32, 1.0, 16.0)),
        'dt_bias_c': dt + jnp.log(-jnp.expm1(-dt)),
        'out_norm_c': 1.0 + nrm(ks[16], (N_ODD, HD_C), 0.1),
        'w_out_odd': nrm(ks[17], (N_ODD, W_C, D_MODEL), W_C ** -0.5),
    }


def reference(x_prompt, x_sample, cache_conv_a, cache_k_b, cache_v_b, state_conv_c, state_s_c,
              norm_pre, norm_post, w_in_even, conv_w_a, rel_bias_b, w_out_even,
              w_in_odd, conv_w_c, a_log_c, dt_bias_c, out_norm_c, w_out_odd):
    yp, ys = x_prompt, x_sample
    ca_p, kb_p, vb_p, cc_p, sc_p = [], [], [], [], []
    ca_s, kb_s, vb_s, cc_s, sc_s = [], [], [], [], []
    for layer in range(DEPTH):
        i = layer // 2
        if layer % 2 == 0:
            wts = (w_in_even[i], conv_w_a[i], rel_bias_b[i], w_out_even[i])
            hist0 = jnp.zeros((yp.shape[0], CONV_A_W - 1, W_A), yp.dtype)
            out, hst, nk, nv = mixer_even(rmsnorm(yp, norm_pre[layer]), hist0, None, None, *wts)
            yp = yp + rmsnorm(out, norm_post[layer])
            ca_p.append(hst)
            kb_p.append(nk)
            vb_p.append(nv)
            out, hst, nk, nv = mixer_even(rmsnorm(ys, norm_pre[layer]), cache_conv_a[i], cache_k_b[i], cache_v_b[i], *wts)
            ys = ys + rmsnorm(out, norm_post[layer])
            ca_s.append(hst)
            kb_s.append(nk)
            vb_s.append(nv)
        else:
            wts = (w_in_odd[i], conv_w_c[i], a_log_c[i], dt_bias_c[i], out_norm_c[i], w_out_odd[i])
            hist0 = jnp.zeros((yp.shape[0], CONV_C_W - 1, 3 * W_C), yp.dtype)
            s0 = jnp.zeros((yp.shape[0], H_C, HD_C, HD_C), jnp.float32)
            out, hst, S = mixer_odd(rmsnorm(yp, norm_pre[layer]), hist0, s0, *wts)
            yp = yp + rmsnorm(out, norm_post[layer])
            cc_p.append(hst)
            sc_p.append(S.astype(x_prompt.dtype))
            out, hst, S = mixer_odd(rmsnorm(ys, norm_pre[layer]), state_conv_c[i], state_s_c[i], *wts)
            ys = ys + rmsnorm(out, norm_post[layer])
            cc_s.append(hst)
            sc_s.append(S.astype(state_s_c.dtype))
    return (yp, ys,
            jnp.stack(ca_p), jnp.stack(kb_p), jnp.stack(vb_p), jnp.stack(cc_p), jnp.stack(sc_p),
            jnp.stack(ca_s), jnp.stack(kb_s), jnp.stack(vb_s), jnp.stack(cc_s), jnp.stack(sc_s))
```

```cpp
#include <hip/hip_runtime.h>
#include <hip/hip_cooperative_groups.h>
#include <cstdio>
namespace cg = cooperative_groups;

#define LAS __attribute__((address_space(3)))
typedef unsigned short u16;
typedef short bf16x8 __attribute__((ext_vector_type(8)));
typedef float f32x4 __attribute__((ext_vector_type(4)));
typedef unsigned u32x4 __attribute__((ext_vector_type(4)));
typedef unsigned u32x2 __attribute__((ext_vector_type(2)));

constexpr int MP = 32768, MS = 2048, MT = MP + MS;
constexpr int LDS_BYTES = 155648;
#ifndef SCAN_FH
#define SCAN_FH 0
#endif
#ifndef DUP
#define DUP 0
#endif
#ifndef DBG_STOP
#define DBG_STOP 99
#endif
constexpr size_t O_YP = 0, O_YS = 33554432, O_CAP = O_YS + 2097152, O_KBP = O_CAP + 32768, O_VBP = O_KBP + 8388608, O_CCP = O_VBP + 8388608,
                 O_SCP = O_CCP + 294912, O_CAS = O_SCP + 4194304, O_KBS = O_CAS + 65536, O_VBS = O_KBS + 2097152, O_CCS = O_VBS + 2097152, O_SCS = O_CCS + 589824;
constexpr size_t SLOT = 73984;
constexpr size_t WS_WIE = 0;
constexpr size_t WS_WOE = WS_WIE + (size_t)2 * 4096 * 1024 * 2;
constexpr size_t WS_WIO = WS_WOE + (size_t)2 * 1024 * 1024 * 2;
constexpr size_t WS_WOO = WS_WIO + (size_t)2 * 4352 * 1024 * 2;
constexpr size_t WS_H   = WS_WOO + (size_t)2 * 1024 * 1024 * 2;
constexpr size_t WS_P   = WS_H + (size_t)MT * 1024 * 2;
constexpr size_t WS_G   = WS_P + (size_t)MT * 4096 * 2;
constexpr size_t WS_GATE= WS_G + (size_t)1280 * SLOT;
constexpr size_t WS_SS  = WS_GATE + (size_t)MT * 16 * 4;
constexpr size_t WS_BAR = WS_SS + (size_t)512 * 32768;
constexpr size_t WS_END = WS_BAR + 16384;
constexpr size_t G_VT = 0, G_KF = (size_t)16 * 512 * 2048 * 2, G_VTS = G_KF + (size_t)32 * 576 * 512 * 2;

struct Params { const float* in[19]; float* out; unsigned char* ws; };

typedef float f32x2_t __attribute__((ext_vector_type(2)));
typedef __bf16 bf16x2_t __attribute__((ext_vector_type(2)));
__device__ __forceinline__ unsigned cvt_pk_bf16(float lo, float hi) { const f32x2_t v = {lo, hi}; const bf16x2_t b = __builtin_convertvector(v, bf16x2_t); return __builtin_bit_cast(unsigned, b); }
__device__ __forceinline__ float bflo(unsigned w) { return __uint_as_float(w << 16); }
__device__ __forceinline__ float bfhi(unsigned w) { return __uint_as_float(w & 0xffff0000u); }
__device__ __forceinline__ float bf2f(u16 h) { return __uint_as_float(((unsigned)h) << 16); }
__device__ __forceinline__ float silu_f(float x) { return x * __builtin_amdgcn_rcpf(1.0f + __builtin_amdgcn_exp2f(-1.4426950408889634f * x)); }
__device__ __forceinline__ u32x2 pack4(f32x4 v) { u32x2 r; r.x = cvt_pk_bf16(v[0], v[1]); r.y = cvt_pk_bf16(v[2], v[3]); return r; }
__device__ __forceinline__ u32x4 pack8(f32x4 a, f32x4 b) { u32x4 r; r.x = cvt_pk_bf16(a[0], a[1]); r.y = cvt_pk_bf16(a[2], a[3]); r.z = cvt_pk_bf16(b[0], b[1]); r.w = cvt_pk_bf16(b[2], b[3]); return r; }
__device__ __forceinline__ bf16x8 as_bf16x8(u32x4 v) { return __builtin_bit_cast(bf16x8, v); }
__device__ __forceinline__ int wave_index() { int w = __builtin_amdgcn_readfirstlane((int)(threadIdx.x >> 6)); return w; }
__device__ __forceinline__ int tid_fresh(int wave_s) { int l; asm volatile("v_mbcnt_lo_u32_b32 %0, -1, 0\n\tv_mbcnt_hi_u32_b32 %0, -1, %0" : "=v"(l)); return wave_s * 64 + l; }
__device__ __forceinline__ float shx(float v, int mask, int lane) { return __int_as_float(__builtin_amdgcn_ds_bpermute((lane ^ mask) << 2, __float_as_int(v))); }
__device__ __forceinline__ float shup(float v, int d, int lane) { return __int_as_float(__builtin_amdgcn_ds_bpermute((lane - d) << 2, __float_as_int(v))); }
__device__ __forceinline__ void lds_barrier() { asm volatile("s_waitcnt lgkmcnt(0)" ::: "memory"); __builtin_amdgcn_s_barrier(); asm volatile("" ::: "memory"); }
#define MFMA16(a, b, c) __builtin_amdgcn_mfma_f32_16x16x32_bf16((a), (b), (c), 0, 0, 0)

namespace pg8 {
constexpr int BM = 256, BK = 64, HALF = 128, HTB = HALF * BK * 2, STAGE_BYTES = 8 * HTB, NXCD = 8, WGM = 8;
__device__ __forceinline__ int lds_byte(int r, int c) { const int st = (r >> 4) * 2 + (c >> 5), rr = r & 15, cc = c & 31, ob = rr * 64 + cc * 2; return st * 1024 + (ob ^ (((ob >> 9) & 1) << 5)); }
__device__ __forceinline__ void stage_rc(int b, int& R, int& C) { const int st = b / 1024, sb = b % 1024, swz = sb ^ (((sb >> 9) & 1) << 5); R = (st >> 1) * 16 + swz / 64; C = (st & 1) * 32 + (swz % 64) / 2; }
__device__ __forceinline__ int perm32(int rho) { const int n = rho >> 4, i = rho & 15; return 8 * (i >> 2) + 4 * n + (i & 3); }
struct Unit { int pm, pn, kind; };
constexpr size_t TSTEP = (size_t)256 * 1024 * 2;

struct StaticOrder {
    int nM, nN, nwg, G, c; const char* A; const char* B;
    __device__ void init(int M, int N, int G_, int c_, const void* A_, const void* B_) { nM = M / BM; nN = N / BM; nwg = nM * nN; G = G_; c = c_; A = (const char*)A_; B = (const char*)B_; }
    __device__ __forceinline__ bool map(long L, Unit& u) const {
        if (L >= nwg) return false;
        int wgid = (int)L; { const int q = nwg / NXCD, r = nwg % NXCD, xcd = wgid % NXCD, off = wgid / NXCD; wgid = (xcd < r ? xcd * (q + 1) : r * (q + 1) + (xcd - r) * q) + off; }
        const int nig = WGM * nN, gid = wgid / nig, fm = gid * WGM, gsz = (nM - fm) < WGM ? (nM - fm) : WGM;
        u.pm = fm + ((wgid % nig) % gsz); u.pn = (wgid % nig) / gsz; u.kind = 0; return true;
    }
    __device__ __forceinline__ bool next(int i, Unit& u) const { return map((long)i * G + c, u); }
    __device__ __forceinline__ const char* aptr(const Unit& u) const { return A + (size_t)u.pm * TSTEP; }
    __device__ __forceinline__ const char* bptr(const Unit& u) const { return B + (size_t)u.pn * TSTEP; }
};
struct OrderEven {
    StaticOrder so; const char* Wv;
    __device__ __forceinline__ bool next(int i, Unit& u) const {
        const long L = (long)i * so.G + so.c;
        if (L < so.nwg) return so.map(L, u);
        if (L < so.nwg + 272) { const int v = (int)(L - so.nwg); u.pm = v & 1; u.pn = v >> 1; u.kind = 1; return true; }
        return false;
    }
    __device__ __forceinline__ const char* aptr(const Unit& u) const { return (u.kind ? Wv : so.A) + (size_t)u.pm * TSTEP; }
    __device__ __forceinline__ const char* bptr(const Unit& u) const { return (u.kind ? so.A : so.B) + (size_t)u.pn * TSTEP; }
};

template <class Epi, class Sched>
__device__ __forceinline__ void gemm_phase(LAS unsigned char* lds, const Sched& S, const Epi& E, int wave_s) {
    int widl = wave_s; asm volatile("" : "+s"(widl)); const int tid = tid_fresh(widl), wid = widl, lane = tid & 63, wr = wid >> 2, wc = wid & 3, fr = lane & 15, fq = lane >> 4;
    constexpr int K = 1024, nt = K / BK;
    unsigned voffA[2], voffB[2];
#pragma unroll
    for (int i = 0; i < 2; ++i) { int R, C; stage_rc(tid * 16 + i * 8192, R, C); const int Rb = (R & ~31) + perm32(R & 31);
        voffA[i] = (unsigned)(R * K + C) * 2u; voffB[i] = (unsigned)(Rb * K + C) * 2u; }
    const size_t kstep = (size_t)(BK * 2);
    const size_t hstep = (size_t)HALF * K * 2;
    const unsigned ldsw = (unsigned)wid * 1024u;
    const int aoff = lds_byte(wr * 64 + fr, fq * 8), boff = lds_byte(wc * 32 + fr, fq * 8);
#define PG8_SA(b, h) (((b) * 2 + (h)) * HTB)
#define PG8_SB(b, h) ((4 + (b) * 2 + (h)) * HTB)
#define PG8_STAGE(bufoff, gbase, voff) do { _Pragma("unroll") for (int _i = 0; _i < 2; ++_i) \
        __builtin_amdgcn_global_load_lds((const unsigned*)((const char*)(gbase) + (voff)[_i]), (LAS unsigned*)(lds + (bufoff) + ldsw + _i * 8192), 16, 0, 0); } while (0)
#define PG8_LDA(dst, b, h) do { _Pragma("unroll") for (int m = 0; m < 4; ++m) _Pragma("unroll") for (int k = 0; k < 2; ++k) dst[m][k] = *(const LAS bf16x8*)(lds + PG8_SA(b, h) + aoff + m * 2048 + k * 1024); } while (0)
#define PG8_LDB(dst, b, h) do { _Pragma("unroll") for (int n = 0; n < 2; ++n) _Pragma("unroll") for (int k = 0; k < 2; ++k) dst[n][k] = *(const LAS bf16x8*)(lds + PG8_SB(b, h) + boff + n * 2048 + k * 1024); } while (0)
#define PG8_MMA(ai, bj, At, Bt) do { __builtin_amdgcn_s_setprio(1); _Pragma("unroll") for (int m = 0; m < 4; ++m) _Pragma("unroll") for (int n = 0; n < 2; ++n) _Pragma("unroll") for (int k = 0; k < 2; ++k) \
        acc[ai][bj][m][n] = __builtin_amdgcn_mfma_f32_16x16x32_bf16(Bt[n][k], At[m][k], acc[ai][bj][m][n], 0, 0, 0); __builtin_amdgcn_s_setprio(0); } while (0)
#define PG8_WAIT_V(n) asm volatile("s_waitcnt vmcnt(" #n ")" ::: "memory")
#define PG8_WAIT_L(n) asm volatile("s_waitcnt lgkmcnt(" #n ")" ::: "memory")
#define PG8_BAR __builtin_amdgcn_s_barrier()
#define PG8_SCHED __builtin_amdgcn_sched_barrier(0)
    Unit cur, nxt; int ui = 0;
    (void)S.next(0, cur);
    f32x4 acc[2][2][4][2];
#pragma unroll
    for (int a = 0; a < 2; ++a)
#pragma unroll
        for (int b = 0; b < 2; ++b)
#pragma unroll
            for (int m = 0; m < 4; ++m)
#pragma unroll
                for (int n = 0; n < 2; ++n) acc[a][b][m][n] = (f32x4){0.f, 0.f, 0.f, 0.f};
    bf16x8 At[4][2], B0[2][2], B1[2][2];
    const char* cA = S.aptr(cur); const char* cB = S.bptr(cur);
    PG8_STAGE(PG8_SB(0, 0), cB, voffB); PG8_STAGE(PG8_SA(0, 0), cA, voffA); PG8_STAGE(PG8_SB(0, 1), cB + hstep, voffB); PG8_STAGE(PG8_SA(0, 1), cA + hstep, voffA);
    if (wr == 1) PG8_BAR;
    PG8_WAIT_V(4); PG8_BAR;
    PG8_STAGE(PG8_SB(1, 0), cB + kstep, voffB); PG8_STAGE(PG8_SA(1, 0), cA + kstep, voffA); PG8_STAGE(PG8_SB(1, 1), cB + hstep + kstep, voffB);
    PG8_WAIT_V(6); PG8_BAR;
    for (;;) {
        const bool has_next = S.next(ui + 1, nxt);
        const char* nA = has_next ? S.aptr(nxt) : cA; const char* nB = has_next ? S.bptr(nxt) : cB;
        for (int t = 0; t < nt; t += 2) {
            const bool last = (t == nt - 2);
            const char* a1 = cA + (size_t)(t + 1) * kstep;
            const char* a2 = last ? nA : cA + (size_t)(t + 2) * kstep; const char* b2 = last ? nB : cB + (size_t)(t + 2) * kstep;
            const char* a3 = a2 + kstep; const char* b3 = b2 + kstep;
            PG8_LDB(B0, 0, 0); PG8_SCHED; PG8_LDA(At, 0, 0); PG8_STAGE(PG8_SA(1, 1), a1 + hstep, voffA);
            PG8_WAIT_L(8); PG8_BAR; PG8_WAIT_L(0); PG8_MMA(0, 0, At, B0); PG8_BAR; PG8_SCHED;
            PG8_LDB(B1, 0, 1); PG8_STAGE(PG8_SB(0, 0), b2, voffB);
            PG8_BAR; PG8_WAIT_L(0); PG8_MMA(0, 1, At, B1); PG8_BAR;
            PG8_LDA(At, 0, 1); PG8_STAGE(PG8_SA(0, 0), a2, voffA);
            PG8_BAR; PG8_WAIT_L(0); PG8_MMA(1, 0, At, B0); PG8_BAR; PG8_SCHED;
            PG8_STAGE(PG8_SB(0, 1), b2 + hstep, voffB);
            PG8_WAIT_V(6); PG8_BAR; PG8_MMA(1, 1, At, B1); PG8_BAR;
            PG8_LDB(B0, 1, 0); PG8_SCHED; PG8_LDA(At, 1, 0); PG8_STAGE(PG8_SA(0, 1), a2 + hstep, voffA);
            PG8_WAIT_L(8); PG8_BAR; PG8_WAIT_L(0); PG8_MMA(0, 0, At, B0); PG8_BAR; PG8_SCHED;
            PG8_LDB(B1, 1, 1); PG8_STAGE(PG8_SB(1, 0), b3, voffB);
            PG8_BAR; PG8_WAIT_L(0); PG8_MMA(0, 1, At, B1); PG8_BAR;
            PG8_LDA(At, 1, 1); PG8_STAGE(PG8_SA(1, 0), a3, voffA);
            PG8_BAR; PG8_WAIT_L(0); PG8_MMA(1, 0, At, B0); PG8_BAR; PG8_SCHED;
            PG8_STAGE(PG8_SB(1, 1), b3 + hstep, voffB);
            PG8_WAIT_V(6); PG8_BAR; PG8_MMA(1, 1, At, B1); PG8_BAR;
        }
        E(acc, cur, wr, wc, fr, fq);
        if (!has_next) break;
#pragma unroll
        for (int a = 0; a < 2; ++a)
#pragma unroll
            for (int b = 0; b < 2; ++b)
#pragma unroll
                for (int m = 0; m < 4; ++m)
#pragma unroll
                    for (int n = 0; n < 2; ++n) acc[a][b][m][n] = (f32x4){0.f, 0.f, 0.f, 0.f};
        cur = nxt; cA = nA; cB = nB; ++ui;
    }
    PG8_WAIT_V(0);
    if (wr == 0) PG8_BAR;
    PG8_BAR;
#undef PG8_SA
#undef PG8_SB
#undef PG8_STAGE
#undef PG8_LDA
#undef PG8_LDB
#undef PG8_MMA
#undef PG8_WAIT_V
#undef PG8_WAIT_L
#undef PG8_BAR
#undef PG8_SCHED
}
}

struct EpiInEven {
    u16* P; u16* VT; u16* KF; u16* VTS; float* out; int i;
    __device__ __forceinline__ void operator()(const f32x4 (&acc)[2][2][4][2], const pg8::Unit& u, int wr, int wc, int fr, int fq) const {
        if (u.kind == 0) {
            const int row0 = u.pm * 256 + wr * 64 + fr, colb = u.pn * 256 + wc * 32 + 8 * fq;
            const bool isk = (u.pn == 10) || (u.pn == 11);
#pragma unroll
            for (int ai = 0; ai < 2; ++ai)
#pragma unroll
                for (int m = 0; m < 4; ++m) {
                    const int row = row0 + ai * 128 + m * 16;
#pragma unroll
                    for (int bj = 0; bj < 2; ++bj) {
                        const int col = colb + bj * 128; const f32x4 v0 = acc[ai][bj][m][0], v1 = acc[ai][bj][m][1];
                        const u32x4 w = pack8(v0, v1);
                        if (u.pn < 4) { *(u32x2*)(P + (size_t)row * 4096 + ((col >> 3) << 2)) = pack4(v0 * v1); }
                        else if (u.pn < 8) { f32x4 gg; gg[0] = v0[0] * silu_f(v1[0]); gg[1] = v0[1] * silu_f(v1[1]); gg[2] = v0[2] * silu_f(v1[2]); gg[3] = v0[3] * silu_f(v1[3]);
                            *(u32x2*)(P + (size_t)row * 4096 + 512 + (((col - 1024) >> 3) << 2)) = pack4(gg); }
                        else *(u32x4*)(P + (size_t)row * 4096 + col) = w;
                        if (isk) {
                            const int kc = col - 2560;
                            if (row < MP) { const int b = row >> 11, t = row & 2047;
                                if (t >= 1536) { float* d = out + O_KBP + ((size_t)(i * 16 + b) * 512 + (t - 1536)) * 512 + kc; *(f32x4*)d = v0; *(f32x4*)(d + 4) = v1; } }
                            else { const int sb = (row - MP) >> 6, t = row & 63;
                                float* d = out + O_KBS + ((size_t)(i * 32 + sb) * 64 + t) * 512 + kc; *(f32x4*)d = v0; *(f32x4*)(d + 4) = v1;
                                *(u32x4*)(KF + ((size_t)sb * 576 + 512 + t) * 512 + kc) = w; }
                        }
                    }
                }
        } else {
            const int d0 = u.pm * 256 + wr * 64 + fr, tokb = u.pn * 256 + wc * 32 + 8 * fq;
#pragma unroll
            for (int ai = 0; ai < 2; ++ai)
#pragma unroll
                for (int m = 0; m < 4; ++m) {
                    const int dd = d0 + ai * 128 + m * 16;
#pragma unroll
                    for (int bj = 0; bj < 2; ++bj) {
                        const int tok = tokb + bj * 128; const f32x4 v0 = acc[ai][bj][m][0], v1 = acc[ai][bj][m][1];
                        const u32x4 w = pack8(v0, v1);
                        if (tok < MP) { const int b = tok >> 11, t = tok & 2047;
                            *(u32x4*)(VT + ((size_t)b * 512 + dd) * 2048 + t) = w;
                            if (t >= 1536) { float* d = out + O_VBP + ((size_t)(i * 16 + b) * 512 + (t - 1536)) * 512 + dd;
                                d[0] = v0[0]; d[512] = v0[1]; d[1024] = v0[2]; d[1536] = v0[3]; d[2048] = v1[0]; d[2560] = v1[1]; d[3072] = v1[2]; d[3584] = v1[3]; } }
                        else { const int sb = (tok - MP) >> 6, t = tok & 63;
                            *(u32x4*)(VTS + ((size_t)sb * 512 + dd) * 576 + 512 + t) = w;
                            float* d = out + O_VBS + ((size_t)(i * 32 + sb) * 64 + t) * 512 + dd;
                            d[0] = v0[0]; d[512] = v0[1]; d[1024] = v0[2]; d[1536] = v0[3]; d[2048] = v1[0]; d[2560] = v1[1]; d[3072] = v1[2]; d[3584] = v1[3]; }
                    }
                }
        }
    }
};
struct EpiInOdd {
    u16* P; float* GATE;
    __device__ __forceinline__ void operator()(const f32x4 (&acc)[2][2][4][2], const pg8::Unit& u, int wr, int wc, int fr, int fq) const {
        const int row0 = u.pm * 256 + wr * 64 + fr, colb = u.pn * 256 + wc * 32 + 8 * fq;
        if (u.pn < 16) {
#pragma unroll
            for (int ai = 0; ai < 2; ++ai)
#pragma unroll
                for (int m = 0; m < 4; ++m) {
                    const int row = row0 + ai * 128 + m * 16;
#pragma unroll
                    for (int bj = 0; bj < 2; ++bj) *(u32x4*)(P + (size_t)row * 4096 + colb + bj * 128) = pack8(acc[ai][bj][m][0], acc[ai][bj][m][1]);
                }
        } else if (wc == 0 && fq < 2) {
#pragma unroll
            for (int ai = 0; ai < 2; ++ai)
#pragma unroll
                for (int m = 0; m < 4; ++m) {
                    const int row = row0 + ai * 128 + m * 16; float* d = GATE + (size_t)row * 16 + 8 * fq;
                    *(f32x4*)d = acc[ai][0][m][0]; *(f32x4*)(d + 4) = acc[ai][0][m][1];
                }
        }
    }
};
struct EpiOut {
    u16* O;
    __device__ __forceinline__ void operator()(const f32x4 (&acc)[2][2][4][2], const pg8::Unit& u, int wr, int wc, int fr, int fq) const {
        const int row0 = u.pm * 256 + wr * 64 + fr, colb = u.pn * 256 + wc * 32 + 8 * fq;
#pragma unroll
        for (int ai = 0; ai < 2; ++ai)
#pragma unroll
            for (int m = 0; m < 4; ++m) {
                const int row = row0 + ai * 128 + m * 16;
#pragma unroll
                for (int bj = 0; bj < 2; ++bj) *(u32x4*)(O + (size_t)row * 1024 + colb + bj * 128) = pack8(acc[ai][bj][m][0], acc[ai][bj][m][1]);
            }
    }
};

__device__ __forceinline__ void transpose_tile(const float* src, size_t sld, int cvalid, u16* dst, size_t dld, LAS float* t, int tid, const float* src2 = nullptr) {
    { const int r = tid >> 4, c4 = (tid & 15) * 4; const float* sp = src2 ? (((c4 & 4) ? src2 : src) + (c4 >> 3) * 4) : src + c4;
#pragma unroll
      for (int e = 0; e < 2; ++e) { const int rr = r + 32 * e; f32x4 v = (f32x4){0.f, 0.f, 0.f, 0.f};
          if (c4 < cvalid) v = *(const f32x4*)(sp + (size_t)rr * sld);
          t[rr * 65 + c4] = v[0]; t[rr * 65 + c4 + 1] = v[1]; t[rr * 65 + c4 + 2] = v[2]; t[rr * 65 + c4 + 3] = v[3]; } }
    lds_barrier();
    { const int c = tid >> 3, r8 = (tid & 7) * 8; float v[8];
#pragma unroll
      for (int e = 0; e < 8; ++e) v[e] = t[(r8 + e) * 65 + c];
      u32x4 w; w.x = cvt_pk_bf16(v[0], v[1]); w.y = cvt_pk_bf16(v[2], v[3]); w.z = cvt_pk_bf16(v[4], v[5]); w.w = cvt_pk_bf16(v[6], v[7]);
      *(u32x4*)(dst + (size_t)c * dld + r8) = w; }
    lds_barrier();
}

__device__ void phase_prep_weights(const Params& p, LAS unsigned char* lds, int wave_s, int odd, int i_sel, int rank, int count) {
    const int tid = tid_fresh(wave_s); LAS float* t = (LAS float*)lds;
    const int ntile = odd ? 1344 : 1280;
    for (int tt = rank; tt < ntile; tt += count) {
        const int it = odd ? (tt < 1088 ? 2560 + i_sel * 1088 + tt : 4736 + i_sel * 256 + (tt - 1088)) : (tt < 1024 ? i_sel * 1024 + tt : 2048 + i_sel * 256 + (tt - 1024));
        int x = it; const float* src; size_t sld; int cvalid = 64; u16* dst;
        const float* src2 = nullptr;
        if (x < 2048) { const int i = x >> 10, r = x & 1023, nb = r >> 4, kb = r & 15, n0 = nb * 64; const int on = n0 < 3072 ? n0 : (n0 < 3584 ? n0 + 512 : n0 - 512);
            src = p.in[9] + (size_t)i * 1024 * 4096 + (size_t)(kb * 64) * 4096 + on; sld = 4096;
            if (n0 < 2048) { const float* wb = p.in[9] + (size_t)i * 1024 * 4096 + (size_t)(kb * 64) * 4096; const int m0 = n0 & 1023, cho = (m0 >> 3) * 4;
                if (n0 < 1024) { src = wb + 512 + cho; src2 = wb + 1024 + cho; } else { src = wb + cho; src2 = wb + 1536 + cho; } }
            dst = (u16*)(p.ws + WS_WIE) + (size_t)i * 4096 * 1024 + (size_t)n0 * 1024 + kb * 64; }
        else if (x < 2560) { x -= 2048; const int i = x >> 8, r = x & 255, nb = r >> 4, kb = r & 15;
            src = p.in[12] + (size_t)i * 1024 * 1024 + (size_t)(kb * 64) * 1024 + nb * 64; sld = 1024;
            dst = (u16*)(p.ws + WS_WOE) + (size_t)i * 1024 * 1024 + (size_t)(nb * 64) * 1024 + kb * 64; }
        else if (x < 4736) { x -= 2560; const int i = x / 1088, r = x % 1088, nb = r >> 4, kb = r & 15, n0 = nb * 64;
            cvalid = 4112 - n0; cvalid = cvalid > 64 ? 64 : (cvalid < 0 ? 0 : cvalid);
            src = p.in[13] + (size_t)i * 1024 * 4112 + (size_t)(kb * 64) * 4112 + n0; sld = 4112;
            dst = (u16*)(p.ws + WS_WIO) + (size_t)i * 4352 * 1024 + (size_t)n0 * 1024 + kb * 64; }
        else { x -= 4736; const int i = x >> 8, r = x & 255, nb = r >> 4, kb = r & 15;
            src = p.in[18] + (size_t)i * 1024 * 1024 + (size_t)(kb * 64) * 1024 + nb * 64; sld = 1024;
            dst = (u16*)(p.ws + WS_WOO) + (size_t)i * 1024 * 1024 + (size_t)(nb * 64) * 1024 + kb * 64; }
        transpose_tile(src, sld, cvalid, dst, 1024, t, tid, src2);
    }
}
__device__ void phase_prep_cache(const Params& p, int i, LAS unsigned char* lds, int wave_s, int rank, int count) {
    const int tid = tid_fresh(wave_s); LAS float* t = (LAS float*)lds;
    u16* KF = (u16*)(p.ws + WS_G + G_KF); u16* VTS = (u16*)(p.ws + WS_G + G_VTS);
    const float* ck = p.in[3] + (size_t)i * 32 * 512 * 512; const float* cv = p.in[4] + (size_t)i * 32 * 512 * 512;
    for (int it = rank; it < 2048; it += count) {
        const int b = it >> 6, h = (it >> 3) & 7, jt = it & 7;
        transpose_tile(cv + ((size_t)b * 512 + jt * 64) * 512 + h * 64, 512, 64, VTS + ((size_t)b * 512 + h * 64) * 576 + jt * 64, 576, t, tid);
    }
    for (size_t e = ((size_t)rank * 512 + tid) * 4; e < (size_t)32 * 512 * 512; e += (size_t)count * 512 * 4) {
        const f32x4 v = *(const f32x4*)(ck + e); const size_t b = e >> 18, rem = e & 262143;
        *(u32x2*)(KF + b * 576 * 512 + rem) = pack4(v);
    }
}

__device__ void phase_norm(const Params& p, bool from_inputs, const u16* o, const float* gpost, const float* gpre, int dst_mode, int wave_s) {
    const int tidn = tid_fresh(wave_s); const int lane = tidn & 63, wv = tidn >> 6;
    u16* H = (u16*)(p.ws + WS_H);
    const int stride = gridDim.x * 8;
    for (int row0 = blockIdx.x * 8 + wv; row0 < MT; row0 += 2 * stride) {
        const int rows[2] = {row0, row0 + stride};
        f32x4 x[2][4]; f32x4 ov[2][4];
#pragma unroll
        for (int u = 0; u < 2; ++u) { const int row = rows[u]; if (row < MT) {
            if (from_inputs) { const float* xs = row < MP ? p.in[0] + (size_t)row * 1024 : p.in[1] + (size_t)(row - MP) * 1024;
#pragma unroll
                for (int s = 0; s < 4; ++s) x[u][s] = *(const f32x4*)(xs + s * 256 + lane * 4); }
            else { const u16* xb = (const u16*)(p.out + (size_t)row * 1024);
#pragma unroll
                for (int s = 0; s < 4; ++s) { const u32x2 w = *(const u32x2*)(xb + s * 256 + lane * 4); x[u][s] = (f32x4){bflo(w.x), bfhi(w.x), bflo(w.y), bfhi(w.y)}; } }
            if (o) {
#pragma unroll
                for (int s = 0; s < 4; ++s) { const u32x2 w = *(const u32x2*)(o + (size_t)row * 1024 + s * 256 + lane * 4); ov[u][s] = (f32x4){bflo(w.x), bfhi(w.x), bflo(w.y), bfhi(w.y)}; }
            } } }
#pragma unroll
        for (int u = 0; u < 2; ++u) { const int row = rows[u]; if (row < MT) {
            if (o) {
                float ss = 0.f;
#pragma unroll
                for (int s = 0; s < 4; ++s) ss += ov[u][s][0] * ov[u][s][0] + ov[u][s][1] * ov[u][s][1] + ov[u][s][2] * ov[u][s][2] + ov[u][s][3] * ov[u][s][3];
#pragma unroll
                for (int off = 32; off; off >>= 1) ss += shx(ss, off, lane);
                const float rstd = rsqrtf(ss * (1.0f / 1024.0f) + 1e-6f);
#pragma unroll
                for (int s = 0; s < 4; ++s) { const f32x4 g = *(const f32x4*)(gpost + s * 256 + lane * 4); x[u][s] += ov[u][s] * rstd * g; }
            }
            if (dst_mode == 2) {
#pragma unroll
                for (int s = 0; s < 4; ++s) *(f32x4*)(p.out + (size_t)row * 1024 + s * 256 + lane * 4) = x[u][s];
            } else if (dst_mode == 1) { u16* xb = (u16*)(p.out + (size_t)row * 1024);
#pragma unroll
                for (int s = 0; s < 4; ++s) *(u32x2*)(xb + s * 256 + lane * 4) = pack4(x[u][s]);
            }
            if (gpre) {
                float ss = 0.f;
#pragma unroll
                for (int s = 0; s < 4; ++s) ss += x[u][s][0] * x[u][s][0] + x[u][s][1] * x[u][s][1] + x[u][s][2] * x[u][s][2] + x[u][s][3] * x[u][s][3];
#pragma unroll
                for (int off = 32; off; off >>= 1) ss += shx(ss, off, lane);
                const float rstd = rsqrtf(ss * (1.0f / 1024.0f) + 1e-6f);
#pragma unroll
                for (int s = 0; s < 4; ++s) { const f32x4 g = *(const f32x4*)(gpre + s * 256 + lane * 4);
                    *(u32x2*)(H + (size_t)row * 1024 + s * 256 + lane * 4) = pack4(x[u][s] * rstd * g); }
            } } }
    }
}

__device__ __forceinline__ void att_tile(const LAS u16* Kc, const LAS float* bt, float bconst, int jt, int hh, int qi0, int fr, int fq, int lane,
                                         const bf16x8 (&qf)[2], f32x4 (&oacc)[4], float& mrun, float& lsum) {
    const LAS u16* Vc = Kc + 9216;
            f32x4 s[4];
#pragma unroll
            for (int kt = 0; kt < 4; ++kt) { s[kt] = (f32x4){0.f, 0.f, 0.f, 0.f};
#pragma unroll
                for (int ks = 0; ks < 2; ++ks) { const bf16x8 a = *(const LAS bf16x8*)(Kc + (hh * 64 + kt * 16 + fr) * 72 + ks * 32 + fq * 8); s[kt] = MFMA16(a, qf[ks], s[kt]); } }
            const int qi = qi0 + fr; float mx = -1e30f;
            if (jt <= 3) {
#pragma unroll
                for (int kt = 0; kt < 4; ++kt)
#pragma unroll
                    for (int r = 0; r < 4; ++r) { const float v = s[kt][r] * 0.18033688011112042f + bconst; s[kt][r] = v; mx = fmaxf(mx, v); }
            } else if (jt == 4) {
#pragma unroll
                for (int kt = 0; kt < 4; ++kt)
#pragma unroll
                    for (int r = 0; r < 4; ++r) { const int j = 64 * jt + kt * 16 + 4 * fq + r; int idx = qi - j + 768; idx = idx > 512 ? 512 : idx;
                        const float v = s[kt][r] * 0.18033688011112042f + bt[hh * 513 + idx]; s[kt][r] = v; mx = fmaxf(mx, v); }
            } else {
                const LAS float* bb = bt + hh * 513 + (qi - 64 * jt - 4 * fq + 768);
#pragma unroll
                for (int kt = 0; kt < 4; ++kt)
#pragma unroll
                    for (int r = 0; r < 4; ++r) { const float v = s[kt][r] * 0.18033688011112042f + bb[-(kt * 16 + r)]; s[kt][r] = v; mx = fmaxf(mx, v); }
            }
            mx = fmaxf(mx, shx(mx, 16, lane)); mx = fmaxf(mx, shx(mx, 32, lane));
            if (__any(mx > mrun)) {
                const float mnew = fmaxf(mrun, mx), alpha = __builtin_amdgcn_exp2f(mrun - mnew); mrun = mnew;
                lsum *= alpha;
#pragma unroll
                for (int dt = 0; dt < 4; ++dt) oacc[dt] *= alpha;
            }
            float ps = 0.f;
#pragma unroll
            for (int kt = 0; kt < 4; ++kt)
#pragma unroll
                for (int r = 0; r < 4; ++r) { const float pv = __builtin_amdgcn_exp2f(s[kt][r] - mrun); s[kt][r] = pv; ps += pv; }
            lsum += ps;
#pragma unroll
            for (int ks2 = 0; ks2 < 2; ++ks2) { const bf16x8 pb = as_bf16x8(pack8(s[2 * ks2], s[2 * ks2 + 1]));
#pragma unroll
                for (int dt = 0; dt < 4; ++dt) { const LAS u16* vr = Vc + (hh * 64 + dt * 16 + fr) * 72 + ks2 * 32 + 4 * fq;
                    const u32x2 lo = *(const LAS u32x2*)vr, hi = *(const LAS u32x2*)(vr + 16);
                    u32x4 va; va.x = lo.x; va.y = lo.y; va.z = hi.x; va.w = hi.y;
                    oacc[dt] = MFMA16(as_bf16x8(va), pb, oacc[dt]); } }
}

__device__ void phase_attn(const Params& p, int i, LAS unsigned char* lds, int wave_s) {
    const int tid = tid_fresh(wave_s), w = wave_s, lane = tid & 63, fr = lane & 15, fq = lane >> 4, hh = w >> 2, qi0 = (w & 3) * 16;
    const u16* P = (const u16*)(p.ws + WS_P); u16* YM = (u16*)(p.ws + WS_H);
    const u16* VT = (const u16*)(p.ws + WS_G + G_VT); const u16* KF = (const u16*)(p.ws + WS_G + G_KF); const u16* VTS = (const u16*)(p.ws + WS_G + G_VTS);
    LAS u16* Ks = (LAS u16*)lds;
    LAS float* bt = (LAS float*)(lds + 73728);
    const float* convw = p.in[10] + (size_t)i * 3 * 512; const float* relb = p.in[11] + (size_t)i * 8 * 513;
    const bool xmap = false; const int bx = blockIdx.x & 7, bs = blockIdx.x >> 3;
    const int nmine = xmap ? (bs < 8 ? 10 : 8) : (2176 - (int)blockIdx.x + (int)gridDim.x - 1) / (int)gridDim.x;
    int hp_loaded = -1;
    for (int iq = 0; iq < nmine; ++iq) {
        int cid, hp;
        if (xmap) { if (iq < 8) { const int g = bx * 8 + iq; cid = (g >> 2) * 32 + bs; hp = g & 3; } else { const int j = bx + 8 * (2 * bs + (iq - 8)); cid = 512 + (j >> 2); hp = j & 3; } }
        else { const int it = blockIdx.x + iq * gridDim.x; cid = it >> 2; hp = it & 3; }
        if (cid < 512) cid = (cid & ~31) | (((cid & 31) + 5 * (cid >> 5)) & 31);
        const bool samp = cid >= 512; const int b = samp ? cid - 512 : (cid >> 5); const int c = samp ? 0 : (cid & 31);
        const long rowbase = (long)cid * 64;
        if (hp != hp_loaded) {
            lds_barrier();
            for (int x = tid; x < 1026; x += 512) { const int h2 = x >= 513 ? 1 : 0; bt[x] = relb[(2 * hp + h2) * 513 + (x - 513 * h2)] * 1.4426950408889634f; }
            hp_loaded = hp;
        }
        const int h = 2 * hp + hh;
        const u16* Kb; long kst; const u16* Vb; long vst; long tstart; int jt0;
        if (!samp) { Kb = P + (size_t)b * 2048 * 4096 + 2560; kst = 4096; Vb = VT + (size_t)b * 512 * 2048; vst = 2048; tstart = (long)c * 64 - 512; jt0 = c >= 8 ? 0 : 8 - c; }
        else { Kb = KF + (size_t)b * 576 * 512; kst = 512; Vb = VTS + (size_t)b * 512 * 576; vst = 576; tstart = 0; jt0 = 0; }
        bf16x8 qf[2];
        { const u16* qr = P + (rowbase + qi0 + fr) * 4096 + 2048 + h * 64 + fq * 8; qf[0] = *(const bf16x8*)qr; qf[1] = *(const bf16x8*)(qr + 32); }
        const int lkey = tid >> 3, lpart = tid & 7;
        u32x4 kreg[2], vreg[2];
        u32x4 kreg2[2], vreg2[2];
#define ATT_LOAD(kr_, vr_, jt_) do { const long t0_ = tstart + 64 * (jt_); _Pragma("unroll") for (int e = 0; e < 2; ++e) { \
            kr_[e] = *(const u32x4*)(Kb + (t0_ + lkey) * kst + (2 * hp + e) * 64 + lpart * 8); vr_[e] = *(const u32x4*)(Vb + (long)((2 * hp + e) * 64 + lkey) * vst + t0_ + lpart * 8); } } while (0)
#define ATT_STORE(buf_, kr_, vr_) do { _Pragma("unroll") for (int e = 0; e < 2; ++e) { \
            *(LAS u32x4*)(Ks + (buf_) * 18432 + (e * 64 + lkey) * 72 + lpart * 8) = kr_[e]; *(LAS u32x4*)(Ks + (buf_) * 18432 + 9216 + (e * 64 + lkey) * 72 + lpart * 8) = vr_[e]; } } while (0)
        ATT_LOAD(kreg, vreg, jt0);
        const int ya_ch = hp * 128 + (tid & 15) * 8, ya_t0 = (tid >> 4) * 2;
        u32x4 ya_u[4], ya_g[2];
#pragma unroll
        for (int k = 0; k < 4; ++k) { const int t = ya_t0 - 2 + k;
            if (t >= 0 || (!samp && c > 0)) ya_u[k] = *(const u32x4*)(P + (rowbase + t) * 4096 + ya_ch);
            else ya_u[k] = (u32x4){0u, 0u, 0u, 0u}; }
#pragma unroll
        for (int k2 = 0; k2 < 2; ++k2) ya_g[k2] = *(const u32x4*)(P + (rowbase + ya_t0 + k2) * 4096 + 512 + ya_ch);
        f32x4 oacc[4];
#pragma unroll
        for (int dt = 0; dt < 4; ++dt) oacc[dt] = (f32x4){0.f, 0.f, 0.f, 0.f};
        float mrun = -1e30f, lsum = 0.f;
        lds_barrier(); ATT_STORE(0, kreg, vreg); if (jt0 + 1 <= 8) ATT_LOAD(kreg, vreg, jt0 + 1); if (jt0 + 2 <= 8) ATT_LOAD(kreg2, vreg2, jt0 + 2); lds_barrier();
        const float bconst = bt[hh * 513 + 512];
        int cb2 = 0;
        for (int jt = jt0; jt <= 8; jt += 2) {
            if (jt + 1 <= 8) { ATT_STORE(cb2 ^ 1, kreg, vreg); if (jt + 3 <= 8) ATT_LOAD(kreg, vreg, jt + 3); }
            att_tile(Ks + cb2 * 18432, bt, bconst, jt, hh, qi0, fr, fq, lane, qf, oacc, mrun, lsum);
            lds_barrier(); cb2 ^= 1;
            if (jt + 1 <= 8) {
                if (jt + 2 <= 8) { ATT_STORE(cb2 ^ 1, kreg2, vreg2); if (jt + 4 <= 8) ATT_LOAD(kreg2, vreg2, jt + 4); }
                att_tile(Ks + cb2 * 18432, bt, bconst, jt + 1, hh, qi0, fr, fq, lane, qf, oacc, mrun, lsum);
                lds_barrier(); cb2 ^= 1;
            }
        }
#undef ATT_LOAD
#undef ATT_STORE
        lsum += shx(lsum, 16, lane); lsum += shx(lsum, 32, lane);
        const float inv = 1.0f / lsum;
        { const long row = rowbase + qi0 + fr;
#pragma unroll
          for (int dt = 0; dt < 4; ++dt) { const int col = h * 64 + dt * 16 + 4 * fq; const u32x2 bz = *(const u32x2*)(P + row * 4096 + 3072 + col);
              f32x4 y; y[0] = oacc[dt][0] * inv * silu_f(bflo(bz.x)); y[1] = oacc[dt][1] * inv * silu_f(bfhi(bz.x)); y[2] = oacc[dt][2] * inv * silu_f(bflo(bz.y)); y[3] = oacc[dt][3] * inv * silu_f(bfhi(bz.y));
              *(u32x2*)(YM + row * 1024 + 512 + col) = pack4(y); } }
        {
            const int ch = ya_ch, t0 = ya_t0;
            float u[4][8];
#pragma unroll
            for (int k = 0; k < 4; ++k) { const int t = t0 - 2 + k;
                if (t >= 0 || (!samp && c > 0)) {
#pragma unroll
                    for (int e = 0; e < 4; ++e) { u[k][2 * e] = bflo(ya_u[k][e]); u[k][2 * e + 1] = bfhi(ya_u[k][e]); } }
                else if (samp) { const float* hs = p.in[2] + ((size_t)(i * 32 + b) * 2 + (2 + t)) * 512 + ch;
#pragma unroll
                    for (int e = 0; e < 8; ++e) u[k][e] = hs[e]; }
                else {
#pragma unroll
                    for (int e = 0; e < 8; ++e) u[k][e] = 0.f; } }
            float cw[3][8];
#pragma unroll
            for (int j = 0; j < 3; ++j)
#pragma unroll
                for (int e = 0; e < 8; ++e) cw[j][e] = convw[j * 512 + ch + e];
#pragma unroll
            for (int k2 = 0; k2 < 2; ++k2) { const int t = t0 + k2; const u32x4 gv = ya_g[k2];
                float y[8];
#pragma unroll
                for (int e = 0; e < 8; ++e) { const float cvv = cw[0][e] * u[k2][e] + cw[1][e] * u[k2 + 1][e] + cw[2][e] * u[k2 + 2][e];
                    const float gvv = (e & 1) ? bfhi(gv[e >> 1]) : bflo(gv[e >> 1]);
                    y[e] = gvv * cvv; }
                u32x4 wv; wv.x = cvt_pk_bf16(y[0], y[1]); wv.y = cvt_pk_bf16(y[2], y[3]); wv.z = cvt_pk_bf16(y[4], y[5]); wv.w = cvt_pk_bf16(y[6], y[7]);
                *(u32x4*)(YM + (rowbase + t) * 1024 + ch) = wv; }
            if (t0 == 62 && (samp || c == 31)) {
                float* d = samp ? p.out + O_CAS + ((size_t)(i * 32 + b) * 2) * 512 + ch : p.out + O_CAP + ((size_t)(i * 16 + b) * 2) * 512 + ch;
#pragma unroll
                for (int e = 0; e < 8; ++e) { d[e] = u[2][e]; d[512 + e] = u[3][e]; }
            }
        }
    }
}

__device__ void phase_gate_logits(const Params& p, int i, int wave_s, int rank, int count) {
    const int tid = tid_fresh(wave_s), lane = tid & 63, fr = lane & 15, fq = lane >> 4;
    const u16* H = (const u16*)(p.ws + WS_H); const u16* Wg = (const u16*)(p.ws + WS_WIO) + (size_t)i * 4352 * 1024 + (size_t)4096 * 1024; float* GATE = (float*)(p.ws + WS_GATE);
    for (int t = rank * 8 + wave_s; t < MT / 16; t += count * 8) {
        f32x4 acc = (f32x4){0.f, 0.f, 0.f, 0.f};
        const u16* ar = H + (size_t)(t * 16 + fr) * 1024 + fq * 8; const u16* br = Wg + (size_t)fr * 1024 + fq * 8;
#pragma unroll 8
        for (int ks = 0; ks < 32; ++ks) { const bf16x8 a = *(const bf16x8*)(ar + ks * 32); const bf16x8 b = *(const bf16x8*)(br + ks * 32); acc = MFMA16(a, b, acc); }
#pragma unroll
        for (int r = 0; r < 4; ++r) GATE[(size_t)(t * 16 + 4 * fq + r) * 16 + fr] = acc[r];
    }
}

constexpr int HB = 77056;
__device__ void phase_gdn_pre(const Params& p, int i, int pass, LAS unsigned char* lds, int wave_s, bool lite = false) {
    const int tid = tid_fresh(wave_s), half = wave_s >> 2, ht = tid & 255, hw = wave_s & 3, lane = tid & 63, fr = lane & 15, fq = lane >> 4;
    LAS unsigned char* hb = lds + half * HB;
    LAS u16* qn = (LAS u16*)hb; LAS u16* kn = (LAS u16*)(hb + 17408); LAS u16* vb = (LAS u16*)(hb + 34816); LAS float* am = (LAS float*)(hb + 52224); LAS float* tb = (LAS float*)(hb + 69632); LAS float* cwl = (LAS float*)(hb + 70912);
    const u16* P = (const u16*)(p.ws + WS_P); const float* GATE = (const float*)(p.ws + WS_GATE);
    const int nch = pass == 0 ? 1280 : 1024;
    int cw_loaded = -1;
    for (int it = blockIdx.x; it < nch / 2; it += gridDim.x) {
        const int ci = it * 2 + half;
        int h, b, c, slot; bool samp; long rowbase;
        if (ci < 1024) { h = ci & 7; const int cc = (ci >> 3) & 7; b = ci >> 6; c = pass * 8 + cc; slot = (b * 8 + h) * 8 + cc; samp = false; rowbase = (long)b * 2048 + c * 64; }
        else { const int x = ci - 1024; h = x & 7; b = x >> 3; c = 0; slot = 1024 + x; samp = true; rowbase = MP + (long)b * 64; }
        unsigned char* sl = p.ws + WS_G + (size_t)slot * SLOT;
        u16* Wn = (u16*)sl; u16* U0T = (u16*)(sl + 16384); u16* Qg = (u16*)(sl + 32768); u16* Kd = (u16*)(sl + 49152); u16* QK = (u16*)(sl + 65536);
        const bool first = samp || c == 0, lastc = samp || c == 31;
        float gl_b = 0.f, gl_a = 0.f;
        if (hw == 0) { const float* gt = GATE + (size_t)(rowbase + lane) * 16; gl_b = gt[h]; gl_a = gt[8 + h]; }
        u32x4 rc[7], rn[7];
#define PRE_LOADRAW(dst, part_) do { _Pragma("unroll") for (int k = 0; k < 7; ++k) { const int t = (ht >> 4) * 4 - 3 + k; \
            if (t >= 0 || !first) dst[k] = *(const u32x4*)(P + (rowbase + t) * 4096 + (part_) * 1024 + h * 128 + (ht & 15) * 8); else dst[k] = (u32x4){0u, 0u, 0u, 0u}; } } while (0)
        PRE_LOADRAW(rc, 0);
        if ((it & 3) != cw_loaded) {
            lds_barrier();
            for (int x = ht; x < 1536; x += 256) { const int j = x / 384, cch = x % 384; cwl[x] = p.in[14][(size_t)(i * 4 + j) * 3072 + (cch >> 7) * 1024 + h * 128 + (cch & 127)]; }
            cw_loaded = it & 3;
            lds_barrier();
        }
#pragma unroll 1
        for (int part = 0; part < 3; ++part) {
            if (part < 2) PRE_LOADRAW(rn, part + 1);
            const int c8 = (ht & 15) * 8, r0 = (ht >> 4) * 4, chg = part * 1024 + h * 128 + c8;
            float raw[7][8];
#pragma unroll
            for (int k = 0; k < 7; ++k) { const int t = r0 - 3 + k;
                if (t >= 0 || !first) { const u32x4 v = rc[k];
#pragma unroll
                    for (int e = 0; e < 4; ++e) { raw[k][2 * e] = bflo(v[e]); raw[k][2 * e + 1] = bfhi(v[e]); } }
                else if (samp) { const float* s = p.in[5] + ((size_t)(i * 32 + b) * 3 + (3 + t)) * 3072 + chg;
#pragma unroll
                    for (int e = 0; e < 8; ++e) raw[k][e] = s[e]; }
                else {
#pragma unroll
                    for (int e = 0; e < 8; ++e) raw[k][e] = 0.f; } }
            float cw[4][8];
#pragma unroll
            for (int j = 0; j < 4; ++j) { const f32x4 c0 = *(const LAS f32x4*)(cwl + j * 384 + part * 128 + c8), c1 = *(const LAS f32x4*)(cwl + j * 384 + part * 128 + c8 + 4);
#pragma unroll
                for (int e = 0; e < 4; ++e) { cw[j][e] = c0[e]; cw[j][4 + e] = c1[e]; } }
            LAS u16* dstl = part == 0 ? qn : (part == 1 ? kn : vb);
#pragma unroll
            for (int rr = 0; rr < 4; ++rr) { float y[8]; float ss = 0.f;
#pragma unroll
                for (int e = 0; e < 8; ++e) { const float cv = cw[0][e] * raw[rr][e] + cw[1][e] * raw[rr + 1][e] + cw[2][e] * raw[rr + 2][e] + cw[3][e] * raw[rr + 3][e]; y[e] = silu_f(cv); ss += y[e] * y[e]; }
                if (part < 2) { ss += shx(ss, 1, lane); ss += shx(ss, 2, lane); ss += shx(ss, 4, lane); ss += shx(ss, 8, lane);
                    const float sc = rsqrtf(ss + 1e-6f) * (part == 0 ? 0.08838834764831845f : 1.0f);
#pragma unroll
                    for (int e = 0; e < 8; ++e) y[e] *= sc; }
                u32x4 wv; wv.x = cvt_pk_bf16(y[0], y[1]); wv.y = cvt_pk_bf16(y[2], y[3]); wv.z = cvt_pk_bf16(y[4], y[5]); wv.w = cvt_pk_bf16(y[6], y[7]);
                *(LAS u32x4*)(dstl + (r0 + rr) * 136 + c8) = wv; }
            if (lastc && r0 == 60) {
                float* d = samp ? p.out + O_CCS + ((size_t)(i * 32 + b) * 3) * 3072 + chg : p.out + O_CCP + ((size_t)(i * 16 + b) * 3) * 3072 + chg;
#pragma unroll
                for (int k = 0; k < 3; ++k)
#pragma unroll
                    for (int e = 0; e < 8; ++e) d[(size_t)k * 3072 + e] = raw[4 + k][e];
            }
#pragma unroll
            for (int k = 0; k < 7; ++k) rc[k] = rn[k];
        }
        if (hw == 0) { const int l = lane; const float bl = gl_b, al = gl_a;
            const float beta = 1.0f / (1.0f + __expf(-bl)); const float A = __expf(p.in[15][i * 8 + h]); const float xx = al + p.in[16][i * 8 + h];
            const float sp = xx > 20.f ? xx : __logf(1.0f + __expf(xx));   const float g = -A * sp;
            float gc = g;
#pragma unroll
            for (int o = 1; o < 64; o <<= 1) { const float tt = shup(gc, o, lane); if (lane >= o) gc += tt; }
            const float glast = __int_as_float(__builtin_amdgcn_readlane(__float_as_int(gc), 63));
            tb[l] = beta; tb[64 + l] = gc; tb[128 + l] = __expf(gc); tb[192 + l] = __expf(glast - gc); if (l == 0) tb[256] = __expf(glast); }
        lds_barrier();
        { const int lt = half == 0 ? hw : 3 - hw;
#pragma unroll 1
          for (int mt = 0; mt <= lt; ++mt) {
              f32x4 akk = (f32x4){0.f, 0.f, 0.f, 0.f};
#pragma unroll
              for (int ks = 0; ks < 4; ++ks) { const bf16x8 bk = *(const LAS bf16x8*)(kn + (mt * 16 + fr) * 136 + ks * 32 + fq * 8);
                  const bf16x8 ak = *(const LAS bf16x8*)(kn + (lt * 16 + fr) * 136 + ks * 32 + fq * 8); akk = MFMA16(ak, bk, akk); }
#pragma unroll
              for (int r = 0; r < 4; ++r) { const int l = lt * 16 + 4 * fq + r, m = mt * 16 + fr; const float dcy = __expf(tb[64 + l] - tb[64 + m]);
                  am[l * 68 + m] = (m < l) ? tb[l] * akk[r] * dcy : 0.f; }
          } }
        lds_barrier();
        if (!lite) {
        }
        { const bool solver = half == 0 ? ht < 128 : ht >= 128; const int cidx = ht & 127;
        if (solver) { if (!lite) {
          f32x2_t sol[64];
          const unsigned ambase = (unsigned)(unsigned long)am, vbb = (unsigned)(unsigned long)(vb + cidx), knb = (unsigned)(unsigned long)(kn + cidx), tbb = (unsigned)(unsigned long)tb;
#pragma unroll
          for (int l = 0; l < 64; ++l) {
              unsigned ra = ambase + l * 272, va = vbb + l * 272, ka = knb + l * 272, ta = tbb + l * 4;
              if (l >= 2) asm volatile("" : "+v"(ra), "+v"(va), "+v"(ka), "+v"(ta) : "v"(sol[l - 2].x));
              const float beta = *(const LAS float*)(unsigned long)ta, eg = ((const LAS float*)(unsigned long)ta)[128];
              f32x2_t sv; sv.x = bf2f(*(const LAS u16*)(unsigned long)va) * beta; sv.y = bf2f(*(const LAS u16*)(unsigned long)ka) * beta * eg;
              f32x2_t pa[2];
#pragma unroll
              for (int e = 0; e < 2; ++e) pa[e] = (f32x2_t){0.f, 0.f};
#pragma unroll
              for (int m4 = 0; m4 < (l + 3) / 4; ++m4) { const f32x4 a4 = ((const LAS f32x4*)(unsigned long)ra)[m4];
#pragma unroll
                  for (int e = 0; e < 4; ++e) if (4 * m4 + e < l) { const f32x2_t aa = {a4[e], a4[e]}; pa[e & 1] += aa * sol[4 * m4 + e]; } }
              sol[l] = sv - (pa[0] + pa[1]); }
#pragma unroll
          for (int x = 0; x < 8; ++x) { u32x4 wv; wv.x = cvt_pk_bf16(sol[8 * x].x, sol[8 * x + 1].x); wv.y = cvt_pk_bf16(sol[8 * x + 2].x, sol[8 * x + 3].x); wv.z = cvt_pk_bf16(sol[8 * x + 4].x, sol[8 * x + 5].x); wv.w = cvt_pk_bf16(sol[8 * x + 6].x, sol[8 * x + 7].x);
              *(u32x4*)(U0T + cidx * 64 + 8 * x) = wv; }
#pragma unroll
          for (int l = 0; l < 64; ++l) vb[l * 136 + cidx] = (u16)(cvt_pk_bf16(-sol[l].y, 0.f) & 0xffffu);
        } } else {
          { const int l = cidx >> 1, pc = (cidx & 1) * 64; const float eg = tb[128 + l];
#pragma unroll
            for (int x = 0; x < 8; ++x) { const u32x4 v = *(const LAS u32x4*)(qn + l * 136 + pc + x * 8); u32x4 wv;
#pragma unroll
                for (int e = 0; e < 4; ++e) wv[e] = cvt_pk_bf16(bflo(v[e]) * eg, bfhi(v[e]) * eg);
                *(u32x4*)(Qg + l * 128 + pc + x * 8) = wv; } }
          { const int k = cidx;
#pragma unroll
            for (int x = 0; x < 8; ++x) { float y[8];
#pragma unroll
                for (int e = 0; e < 8; ++e) { const int l = x * 8 + e; y[e] = bf2f(kn[l * 136 + k]) * tb[192 + l]; }
                u32x4 wv; wv.x = cvt_pk_bf16(y[0], y[1]); wv.y = cvt_pk_bf16(y[2], y[3]); wv.z = cvt_pk_bf16(y[4], y[5]); wv.w = cvt_pk_bf16(y[6], y[7]);
                *(u32x4*)(Kd + k * 64 + x * 8) = wv; } }
          { const int wsel = cidx >> 6;
#pragma unroll 1
            for (int q2 = 0; q2 < 2; ++q2) { const int lt = wsel == 0 ? (q2 == 0 ? 0 : 3) : (q2 == 0 ? 1 : 2);
#pragma unroll 1
              for (int mt = 0; mt < 4; ++mt) {
                  if (mt <= lt) {
                      f32x4 aqk = (f32x4){0.f, 0.f, 0.f, 0.f};
#pragma unroll
                      for (int ks = 0; ks < 4; ++ks) { const bf16x8 bk = *(const LAS bf16x8*)(kn + (mt * 16 + fr) * 136 + ks * 32 + fq * 8);
                          const bf16x8 aq = *(const LAS bf16x8*)(qn + (lt * 16 + fr) * 136 + ks * 32 + fq * 8); aqk = MFMA16(aq, bk, aqk); }
#pragma unroll
                      for (int r = 0; r < 4; ++r) { const int l = lt * 16 + 4 * fq + r, m = mt * 16 + fr; const float dcy = __expf(tb[64 + l] - tb[64 + m]);
                          const float q = (m <= l) ? aqk[r] * dcy : 0.f; QK[l * 64 + m] = (u16)(cvt_pk_bf16(q, 0.f) & 0xffffu); }
                  } else {
#pragma unroll
                      for (int r = 0; r < 4; ++r) { const int l = lt * 16 + 4 * fq + r, m = mt * 16 + fr; QK[l * 64 + m] = 0; }
                  }
              } } }
        } }
        lds_barrier();
        if (!lite) { const int l = ht >> 2, pc = (ht & 3) * 32;
#pragma unroll
          for (int x = 0; x < 4; ++x) *(u32x4*)(Wn + l * 128 + pc + x * 8) = *(const LAS u32x4*)(vb + l * 136 + pc + x * 8); }
        if (ht == 0) *(float*)(sl + 73728) = tb[256];
        lds_barrier();
    }
}

__device__ void phase_gdn_scan(const Params& p, int i, int pass, LAS unsigned char* lds, int wave_s) {
    const int tid = tid_fresh(wave_s), w = wave_s, lane = tid & 63, fr = lane & 15, fq = lane >> 4;
    LAS u16* St = (LAS u16*)lds;
    LAS u16* uT = (LAS u16*)(lds + 34816);
    u16* ORAW = (u16*)(p.ws + WS_H);
    const int nitems = pass == 0 ? 768 : 256;
    for (int it = blockIdx.x; it < nitems; it += gridDim.x) {
        const bool samp = it >= 256; const int x = samp ? it - 256 : it; const int xb = x & 255;
        const int chain = (xb & 7) + 8 * (xb >> 4) + 128 * (x >> 8), vh = (xb >> 3) & 1, b = chain >> 3, h = chain & 7;
        const int nchunk = samp ? 1 : 8, slot0 = samp ? 1024 + chain : chain * 8;
        const long rowbase0 = samp ? MP + (long)b * 64 : (long)b * 2048 + pass * 512;
        float* ssave_rd = (float*)(p.ws + WS_SS + (size_t)((pass & 1) * 256 + x) * 32768);
        float* ssave_wr = (float*)(p.ws + WS_SS + (size_t)(((pass + 1) & 1) * 256 + x) * 32768);
        f32x4 accS[4];
        const int kt = w;
        if (samp) { const float* s0 = p.in[6] + ((size_t)(i * 32 + b) * 8 + h) * 16384;
#pragma unroll
            for (int vt = 0; vt < 4; ++vt)
#pragma unroll
                for (int r = 0; r < 4; ++r) accS[vt][r] = s0[(kt * 16 + 4 * fq + r) * 128 + vh * 64 + vt * 16 + fr]; }
        else if (pass == 0) {
#pragma unroll
            for (int vt = 0; vt < 4; ++vt) accS[vt] = (f32x4){0.f, 0.f, 0.f, 0.f}; }
        else {
#pragma unroll
            for (int vt = 0; vt < 4; ++vt) accS[vt] = *(const f32x4*)(ssave_rd + ((w * 4 + vt) * 64 + lane) * 4); }
        lds_barrier();
#pragma unroll
        for (int vt = 0; vt < 4; ++vt) *(LAS u32x2*)(St + (vt * 16 + fr) * 136 + kt * 16 + 4 * fq) = pack4(accS[vt]);
        lds_barrier();
        int cur = 0;
        const int lt = w >> 1, vt0 = (w & 1) * 2;
        bf16x8 aW[4], aQ[4], aQK[2], aK[2]; u32x2 aU[2]; float adec = 1.f;
        bf16x8 bW[4], bQ[4], bQK[2], bK[2]; u32x2 bU[2]; float bdec = 1.f;
        bf16x8 cW[4], cQ[4], cQK[2], cK[2]; u32x2 cU[2]; float cdec = 1.f;
#define SCAN_LOAD(W_, Q_, QK_, K_, U_, dec_, slotidx) do { const unsigned char* sl_ = p.ws + WS_G + (size_t)(slotidx) * SLOT; \
            _Pragma("unroll") for (int ks = 0; ks < 4; ++ks) { W_[ks] = *(const bf16x8*)((const u16*)sl_ + (lt * 16 + fr) * 128 + ks * 32 + fq * 8); Q_[ks] = *(const bf16x8*)((const u16*)(sl_ + 32768) + (lt * 16 + fr) * 128 + ks * 32 + fq * 8); } \
            _Pragma("unroll") for (int ks2 = 0; ks2 < 2; ++ks2) { QK_[ks2] = *(const bf16x8*)((const u16*)(sl_ + 65536) + (lt * 16 + fr) * 64 + ks2 * 32 + fq * 8); K_[ks2] = *(const bf16x8*)((const u16*)(sl_ + 49152) + (kt * 16 + fr) * 64 + ks2 * 32 + fq * 8); } \
            _Pragma("unroll") for (int j = 0; j < 2; ++j) U_[j] = *(const u32x2*)((const u16*)(sl_ + 16384) + (vh * 64 + (vt0 + j) * 16 + fr) * 64 + lt * 16 + 4 * fq); \
            dec_ = *(const float*)(sl_ + 73728); } while (0)
#define SCAN_STEP(W_, Q_, QK_, K_, U_, dec_, cc_) do { \
            const long rowbase = rowbase0 + (cc_) * 64; \
            LAS u16* Sc = St + cur * 64 * 136; LAS u16* Sn = St + (cur ^ 1) * 64 * 136; \
            { f32x4 au[2]; \
              _Pragma("unroll") for (int j = 0; j < 2; ++j) au[j] = (f32x4){bflo(U_[j].x), bfhi(U_[j].x), bflo(U_[j].y), bfhi(U_[j].y)}; \
              _Pragma("unroll") for (int ks = 0; ks < 4; ++ks) { \
                  _Pragma("unroll") for (int j = 0; j < 2; ++j) { const bf16x8 bb = *(const LAS bf16x8*)(Sc + ((vt0 + j) * 16 + fr) * 136 + ks * 32 + fq * 8); au[j] = MFMA16(W_[ks], bb, au[j]); } } \
              _Pragma("unroll") for (int j = 0; j < 2; ++j) *(LAS u32x2*)(uT + ((vt0 + j) * 16 + fr) * 72 + lt * 16 + 4 * fq) = pack4(au[j]); } \
            lds_barrier(); \
            { f32x4 ao[2]; \
              _Pragma("unroll") for (int j = 0; j < 2; ++j) ao[j] = (f32x4){0.f, 0.f, 0.f, 0.f}; \
              _Pragma("unroll") for (int ks = 0; ks < 4; ++ks) { \
                  _Pragma("unroll") for (int j = 0; j < 2; ++j) { const bf16x8 a = *(const LAS bf16x8*)(Sc + ((vt0 + j) * 16 + fr) * 136 + ks * 32 + fq * 8); ao[j] = MFMA16(a, Q_[ks], ao[j]); } } \
              _Pragma("unroll") for (int ks2 = 0; ks2 < 2; ++ks2) { \
                  _Pragma("unroll") for (int j = 0; j < 2; ++j) { const bf16x8 a = *(const LAS bf16x8*)(uT + ((vt0 + j) * 16 + fr) * 72 + ks2 * 32 + fq * 8); ao[j] = MFMA16(a, QK_[ks2], ao[j]); } } \
              _Pragma("unroll") for (int j = 0; j < 2; ++j) *(u32x2*)(ORAW + (rowbase + lt * 16 + fr) * 1024 + h * 128 + vh * 64 + (vt0 + j) * 16 + 4 * fq) = pack4(ao[j]); } \
            { _Pragma("unroll") for (int vt = 0; vt < 4; ++vt) accS[vt] *= dec_; \
              _Pragma("unroll") for (int ks2 = 0; ks2 < 2; ++ks2) { \
                  _Pragma("unroll") for (int vt = 0; vt < 4; ++vt) { const bf16x8 bb = *(const LAS bf16x8*)(uT + (vt * 16 + fr) * 72 + ks2 * 32 + fq * 8); accS[vt] = MFMA16(K_[ks2], bb, accS[vt]); } } \
              _Pragma("unroll") for (int vt = 0; vt < 4; ++vt) *(LAS u32x2*)(Sn + (vt * 16 + fr) * 136 + kt * 16 + 4 * fq) = pack4(accS[vt]); } \
            lds_barrier(); \
            cur ^= 1; } while (0)
        SCAN_LOAD(aW, aQ, aQK, aK, aU, adec, slot0);
        if (nchunk > 1) SCAN_LOAD(bW, bQ, bQK, bK, bU, bdec, slot0 + 1);
        for (int cc = 0; cc < nchunk; cc += 3) {
            if (cc + 2 < nchunk) SCAN_LOAD(cW, cQ, cQK, cK, cU, cdec, slot0 + cc + 2);
            SCAN_STEP(aW, aQ, aQK, aK, aU, adec, cc);
            if (cc + 1 < nchunk) {
                if (cc + 3 < nchunk) SCAN_LOAD(aW, aQ, aQK, aK, aU, adec, slot0 + cc + 3);
                SCAN_STEP(bW, bQ, bQK, bK, bU, bdec, cc + 1);
            }
            if (cc + 2 < nchunk) {
                if (cc + 4 < nchunk) SCAN_LOAD(bW, bQ, bQK, bK, bU, bdec, slot0 + cc + 4);
                SCAN_STEP(cW, cQ, cQK, cK, cU, cdec, cc + 2);
            }
        }
#undef SCAN_STEP
#undef SCAN_LOAD
        if (samp || pass == 3) {
            float* d = samp ? p.out + O_SCS + ((size_t)(i * 32 + b) * 8 + h) * 16384 : p.out + O_SCP + ((size_t)(i * 16 + b) * 8 + h) * 16384;
#pragma unroll
            for (int vt = 0; vt < 4; ++vt)
#pragma unroll
                for (int r = 0; r < 4; ++r) d[(kt * 16 + 4 * fq + r) * 128 + vh * 64 + vt * 16 + fr] = accS[vt][r];
        } else {
#pragma unroll
            for (int vt = 0; vt < 4; ++vt) *(f32x4*)(ssave_wr + ((w * 4 + vt) * 64 + lane) * 4) = accS[vt];
        }
    }
}

__device__ void phase_gdn_scan_fh(const Params& p, int i, int pass, LAS unsigned char* lds, int wave_s) {
    const int tid = tid_fresh(wave_s), w = wave_s, lane = tid & 63, fr = lane & 15, fq = lane >> 4;
    LAS u16* St = (LAS u16*)lds;
    LAS u16* uT = (LAS u16*)(lds + 69632);
    LAS float* rs = (LAS float*)(lds + 88064);
    u16* YM = (u16*)(p.ws + WS_H); const u16* P = (const u16*)(p.ws + WS_P);
    const int nitems = pass == 0 ? 384 : 128;
    const int kt = w, lt = w >> 1, vt0 = (w & 1) * 4;
    for (int it = blockIdx.x; it < nitems; it += gridDim.x) {
        const bool samp = it >= 128; const int chain = samp ? it - 128 : it, b = chain >> 3, h = chain & 7;
        const int nchunk = samp ? 1 : 8, slot0 = samp ? 1024 + chain : chain * 8;
        const long rowbase0 = samp ? MP + (long)b * 64 : (long)b * 2048 + pass * 512;
        const float* ssave_rd = (const float*)(p.ws + WS_SS + (size_t)((pass & 1) * 128 + chain) * 65536);
        float* ssave_wr = (float*)(p.ws + WS_SS + (size_t)(((pass + 1) & 1) * 128 + chain) * 65536);
        f32x4 accS[8];
        if (samp) { const float* s0 = p.in[6] + ((size_t)(i * 32 + b) * 8 + h) * 16384;
#pragma unroll
            for (int vt = 0; vt < 8; ++vt)
#pragma unroll
                for (int r = 0; r < 4; ++r) accS[vt][r] = s0[(kt * 16 + 4 * fq + r) * 128 + vt * 16 + fr]; }
        else if (pass == 0) {
#pragma unroll
            for (int vt = 0; vt < 8; ++vt) accS[vt] = (f32x4){0.f, 0.f, 0.f, 0.f}; }
        else {
#pragma unroll
            for (int vt = 0; vt < 8; ++vt) accS[vt] = *(const f32x4*)(ssave_rd + ((w * 8 + vt) * 64 + lane) * 4); }
        lds_barrier();
#pragma unroll
        for (int vt = 0; vt < 8; ++vt) *(LAS u32x2*)(St + (vt * 16 + fr) * 136 + kt * 16 + 4 * fq) = pack4(accS[vt]);
        lds_barrier();
        int cur = 0;
        for (int cc = 0; cc < nchunk; ++cc) {
            const unsigned char* sl = p.ws + WS_G + (size_t)(slot0 + cc) * SLOT;
            const long rowbase = rowbase0 + cc * 64;
            bf16x8 cW[4], cQ[4], cQK[2], cK[2]; u32x2 cU[4], zz[4];
#pragma unroll
            for (int ks = 0; ks < 4; ++ks) { cW[ks] = *(const bf16x8*)((const u16*)sl + (lt * 16 + fr) * 128 + ks * 32 + fq * 8); cQ[ks] = *(const bf16x8*)((const u16*)(sl + 32768) + (lt * 16 + fr) * 128 + ks * 32 + fq * 8); }
#pragma unroll
            for (int ks2 = 0; ks2 < 2; ++ks2) { cQK[ks2] = *(const bf16x8*)((const u16*)(sl + 65536) + (lt * 16 + fr) * 64 + ks2 * 32 + fq * 8); cK[ks2] = *(const bf16x8*)((const u16*)(sl + 49152) + (kt * 16 + fr) * 64 + ks2 * 32 + fq * 8); }
#pragma unroll
            for (int j = 0; j < 4; ++j) { cU[j] = *(const u32x2*)((const u16*)(sl + 16384) + ((vt0 + j) * 16 + fr) * 64 + lt * 16 + 4 * fq);
                zz[j] = *(const u32x2*)(P + (rowbase + lt * 16 + fr) * 4096 + 3072 + h * 128 + (vt0 + j) * 16 + 4 * fq); }
            const float cdec = *(const float*)(sl + 73728);
            LAS u16* Sc = St + cur * 128 * 136; LAS u16* Sn = St + (cur ^ 1) * 128 * 136;
            { f32x4 au[4];
#pragma unroll
              for (int j = 0; j < 4; ++j) au[j] = (f32x4){bflo(cU[j].x), bfhi(cU[j].x), bflo(cU[j].y), bfhi(cU[j].y)};
#pragma unroll
              for (int ks = 0; ks < 4; ++ks) {
#pragma unroll
                  for (int j = 0; j < 4; ++j) { const bf16x8 bb = *(const LAS bf16x8*)(Sc + ((vt0 + j) * 16 + fr) * 136 + ks * 32 + fq * 8); au[j] = MFMA16(cW[ks], bb, au[j]); } }
#pragma unroll
              for (int j = 0; j < 4; ++j) *(LAS u32x2*)(uT + ((vt0 + j) * 16 + fr) * 72 + lt * 16 + 4 * fq) = pack4(au[j]); }
            lds_barrier();
            f32x4 ao[4];
#pragma unroll
            for (int j = 0; j < 4; ++j) ao[j] = (f32x4){0.f, 0.f, 0.f, 0.f};
#pragma unroll
            for (int ks = 0; ks < 4; ++ks) {
#pragma unroll
                for (int j = 0; j < 4; ++j) { const bf16x8 a = *(const LAS bf16x8*)(Sc + ((vt0 + j) * 16 + fr) * 136 + ks * 32 + fq * 8); ao[j] = MFMA16(a, cQ[ks], ao[j]); } }
#pragma unroll
            for (int ks2 = 0; ks2 < 2; ++ks2) {
#pragma unroll
                for (int j = 0; j < 4; ++j) { const bf16x8 a = *(const LAS bf16x8*)(uT + ((vt0 + j) * 16 + fr) * 72 + ks2 * 32 + fq * 8); ao[j] = MFMA16(a, cQK[ks2], ao[j]); } }
            { float ss = 0.f;
#pragma unroll
              for (int j = 0; j < 4; ++j) ss += ao[j][0] * ao[j][0] + ao[j][1] * ao[j][1] + ao[j][2] * ao[j][2] + ao[j][3] * ao[j][3];
              ss += shx(ss, 16, lane); ss += shx(ss, 32, lane);
              if (fq == 0) rs[(lt * 16 + fr) * 2 + (w & 1)] = ss; }
            {
#pragma unroll
              for (int vt = 0; vt < 8; ++vt) accS[vt] *= cdec;
#pragma unroll
              for (int ks2 = 0; ks2 < 2; ++ks2) {
#pragma unroll
                  for (int vt = 0; vt < 8; ++vt) { const bf16x8 bb = *(const LAS bf16x8*)(uT + (vt * 16 + fr) * 72 + ks2 * 32 + fq * 8); accS[vt] = MFMA16(cK[ks2], bb, accS[vt]); } }
#pragma unroll
              for (int vt = 0; vt < 8; ++vt) *(LAS u32x2*)(Sn + (vt * 16 + fr) * 136 + kt * 16 + 4 * fq) = pack4(accS[vt]); }
            lds_barrier();
            { const float tot = rs[(lt * 16 + fr) * 2] + rs[(lt * 16 + fr) * 2 + 1]; const float rstd = rsqrtf(tot * (1.0f / 128.0f) + 1e-6f);
#pragma unroll
              for (int j = 0; j < 4; ++j) { const f32x4 onj = *(const f32x4*)(p.in[17] + i * 128 + (vt0 + j) * 16 + 4 * fq); f32x4 y; y[0] = ao[j][0] * rstd * onj[0] * silu_f(bflo(zz[j].x)); y[1] = ao[j][1] * rstd * onj[1] * silu_f(bfhi(zz[j].x));
                  y[2] = ao[j][2] * rstd * onj[2] * silu_f(bflo(zz[j].y)); y[3] = ao[j][3] * rstd * onj[3] * silu_f(bfhi(zz[j].y));
                  *(u32x2*)(YM + (rowbase + lt * 16 + fr) * 1024 + h * 128 + (vt0 + j) * 16 + 4 * fq) = pack4(y); } }
            cur ^= 1;
        }
        if (samp || pass == 3) {
            float* d = samp ? p.out + O_SCS + ((size_t)(i * 32 + b) * 8 + h) * 16384 : p.out + O_SCP + ((size_t)(i * 16 + b) * 8 + h) * 16384;
#pragma unroll
            for (int vt = 0; vt < 8; ++vt)
#pragma unroll
                for (int r = 0; r < 4; ++r) d[(kt * 16 + 4 * fq + r) * 128 + vt * 16 + fr] = accS[vt][r];
        } else {
#pragma unroll
            for (int vt = 0; vt < 8; ++vt) *(f32x4*)(ssave_wr + ((w * 8 + vt) * 64 + lane) * 4) = accS[vt];
        }
    }
}

__device__ void phase_gdn_gate(const Params& p, int i, int wave_s) {
    const int tidn = tid_fresh(wave_s); const int lane = tidn & 63, wv = tidn >> 6;
    u16* H = (u16*)(p.ws + WS_H); const u16* P = (const u16*)(p.ws + WS_P); const float* onorm = p.in[17] + i * 128;
    for (int row = blockIdx.x * 8 + wv; row < MT; row += gridDim.x * 8) {
#pragma unroll
        for (int s = 0; s < 4; ++s) {
            const u32x2 ow = *(const u32x2*)(H + (size_t)row * 1024 + s * 256 + lane * 4); const u32x2 zw = *(const u32x2*)(P + (size_t)row * 4096 + 3072 + s * 256 + lane * 4);
            f32x4 o = (f32x4){bflo(ow.x), bfhi(ow.x), bflo(ow.y), bfhi(ow.y)}; const f32x4 z = (f32x4){bflo(zw.x), bfhi(zw.x), bflo(zw.y), bfhi(zw.y)};
            float ss = o[0] * o[0] + o[1] * o[1] + o[2] * o[2] + o[3] * o[3];
            ss += shx(ss, 1, lane); ss += shx(ss, 2, lane); ss += shx(ss, 4, lane); ss += shx(ss, 8, lane); ss += shx(ss, 16, lane);
            const float rstd = rsqrtf(ss * (1.0f / 128.0f) + 1e-6f);
            const f32x4 g = *(const f32x4*)(onorm + ((lane * 4) & 127));
            f32x4 y;
#pragma unroll
            for (int e = 0; e < 4; ++e) y[e] = o[e] * rstd * g[e] * silu_f(z[e]);
            *(u32x2*)(H + (size_t)row * 1024 + s * 256 + lane * 4) = pack4(y);
        }
    }
}

__device__ void dbg_dump_u16(const Params& p, const u16* src, size_t n, size_t stride, size_t out_off, int wave_s) {
    const int t = tid_fresh(wave_s);
#pragma unroll 1
    for (size_t e = (size_t)blockIdx.x * 512 + t; e < n; e += (size_t)gridDim.x * 512) p.out[out_off + e] = (float)src[e * stride];
}
__device__ void dbg_dump_f32(const Params& p, const float* src, size_t n, size_t out_off, int wave_s) {
    const int t = tid_fresh(wave_s);
#pragma unroll 1
    for (size_t e = (size_t)blockIdx.x * 512 + t; e < n; e += (size_t)gridDim.x * 512) p.out[out_off + e] = src[e];
}
__device__ __forceinline__ void gsync(cg::grid_group& g, int wave_s) {
    asm volatile("s_waitcnt vmcnt(0) lgkmcnt(0)" ::: "memory");
    __syncthreads();
    g.sync();
    if (wave_s == 0) { const int l = tid_fresh(0);
        if (l == 0) { __builtin_amdgcn_fence(__ATOMIC_ACQUIRE, "agent"); asm volatile("s_waitcnt vmcnt(0)" ::: "memory"); } }
    __syncthreads();
}
typedef const __attribute__((address_space(4))) Params* KParamsPtr;
__device__ __forceinline__ Params kargs() {
#if defined(__HIP_DEVICE_COMPILE__)
    unsigned long k = (unsigned long)__builtin_amdgcn_kernarg_segment_ptr(); asm volatile("" : "+s"(k)); return *(KParamsPtr)k;
#else
    return Params{};
#endif
}
#define XB_TMO      128
#define XB_XCNT(j)  (256  + 64 * (j))
#define XB_XSUB(j)  (1280 + 64 * (j))
#define XB_XGEN(j)  (2304 + 64 * (j))
#define XB_TOP      3328
#define XB_TOPGEN   3392
#define XB_WORDS    3456
#define XB_SPIN_CAP (1u << 22)
__device__ __forceinline__ unsigned xb_ld(unsigned* p)              { return __hip_atomic_load(p, __ATOMIC_RELAXED, __HIP_MEMORY_SCOPE_AGENT); }
__device__ __forceinline__ unsigned xb_add(unsigned* p, unsigned v) { return __hip_atomic_fetch_add(p, v, __ATOMIC_RELAXED, __HIP_MEMORY_SCOPE_AGENT); }
__device__ __forceinline__ unsigned xb_xcc_id() { return (unsigned)__builtin_amdgcn_s_getreg((3 << 11) | 20) & 0xFu; }
#define XB_SPIN(cond, bar) do { unsigned _sp = 0; while (cond) { __builtin_amdgcn_s_sleep(1); \
    if ((++_sp & 255u) == 0u) { if (xb_ld(&(bar)[XB_TMO])) break; if (_sp > XB_SPIN_CAP) { atomicAdd(&(bar)[XB_TMO], 1u); break; } } } } while (0)
__device__ __forceinline__ void xb_complete(unsigned* bar, unsigned x, unsigned G, unsigned& nloc, unsigned& nx) {
    unsigned sum, cnt, mine, sp = 0u;
    for (;;) {
        sum = 0u; cnt = 0u; mine = 0u;
#pragma unroll
        for (unsigned j = 0; j < 16; ++j) { const unsigned c = xb_ld(&bar[XB_XCNT(j)]); sum += c; cnt += (c > 0u) ? 1u : 0u; mine = (j == x) ? c : mine; }
        if (sum == G) break;
        __builtin_amdgcn_s_sleep(1);
        if ((++sp & 255u) == 0u) { if (xb_ld(&bar[XB_TMO])) break; if (sp > XB_SPIN_CAP) { atomicAdd(&bar[XB_TMO], 1u); break; } }
    }
    nloc = mine > 0u ? mine : 1u; nx = cnt > 0u ? cnt : 1u;
}
__device__ __forceinline__ void gbar(unsigned* bar, volatile LAS unsigned* st, int wave_s) {
    asm volatile("s_waitcnt vmcnt(0) lgkmcnt(0)" ::: "memory");
    __syncthreads();
    if (wave_s == 0) { const int l0 = tid_fresh(0);
      if (l0 == 0) {
        const unsigned x = xb_xcc_id();
        unsigned nloc = st[0], nx = st[1];
        if (nloc == 0u) { xb_complete(bar, x, gridDim.x, nloc, nx); st[0] = nloc; st[1] = nx; }
        const unsigned old = xb_add(&bar[XB_XSUB(x)], 1u);
        const unsigned gen = old / nloc;
        if (old + 1u == (gen + 1u) * nloc) {
            __builtin_amdgcn_fence(__ATOMIC_RELEASE, "agent");
            asm volatile("s_waitcnt vmcnt(0)" ::: "memory");
            const unsigned og = xb_add(&bar[XB_TOP], 1u);
            const unsigned tg = og / nx;
            if (og + 1u == (tg + 1u) * nx) xb_add(&bar[XB_TOPGEN], 1u);
            else XB_SPIN(xb_ld(&bar[XB_TOPGEN]) == tg, bar);
            __builtin_amdgcn_fence(__ATOMIC_ACQUIRE, "agent");
            xb_add(&bar[XB_XGEN(x)], 1u);
            asm volatile("s_waitcnt vmcnt(0)" ::: "memory");
        } else {
            XB_SPIN(xb_ld(&bar[XB_XGEN(x)]) == gen, bar);
            __builtin_amdgcn_fence(__ATOMIC_ACQUIRE, "agent");
            asm volatile("s_waitcnt vmcnt(0)" ::: "memory");
        }
      } }
    __syncthreads();
}
__device__ __forceinline__ bool gemm_idle_rank(int nwg, int G, int c, int& rank, int& count) { const int rem = nwg % G; if (rem == 0) { rank = c; count = G; return true; } rank = c - rem; count = G - rem; return c >= rem; }
__global__ void __launch_bounds__(512) mega_fwd(Params p_unused) {
    extern __shared__ __attribute__((aligned(16))) unsigned char smem[];
    LAS unsigned char* lds = (LAS unsigned char*)smem;
    cg::grid_group grid = cg::this_grid();
    const int G = gridDim.x, cb = blockIdx.x;
    const int wave_s = wave_index();
    unsigned* bar; { const Params p = kargs(); bar = (unsigned*)(p.ws + WS_BAR); }
    volatile LAS unsigned* xst = (volatile LAS unsigned*)(lds + 154112);
    { const int t0 = tid_fresh(wave_s); if (t0 == 0) { xst[0] = 0u; xst[1] = 0u; }
      if (cb == 0) for (int w = t0; w < XB_WORDS; w += 512) __hip_atomic_store(bar + w, 0u, __ATOMIC_RELAXED, __HIP_MEMORY_SCOPE_AGENT); }

    phase_prep_weights(kargs(), lds, wave_s, 0, 0, cb, G);
    phase_prep_cache(kargs(), 0, lds, wave_s, cb, G);
    { const Params p = kargs(); phase_norm(p, true, nullptr, nullptr, p.in[7], 0, wave_s); }
    gsync(grid, wave_s);
    if (wave_s == 0 && tid_fresh(0) == 0) (void)xb_add(&bar[XB_XCNT(xb_xcc_id())], 1u);
#pragma unroll 1
    for (int layer = 0; layer < 4; ++layer) {
        const int i = layer >> 1;
        if ((layer & 1) == 0) {
            { const Params p = kargs(); int cbf = cb; asm volatile("" : "+s"(cbf)); pg8::OrderEven S; S.so.init(MT, 3584, G, cbf, p.ws + WS_H, p.ws + WS_WIE + (size_t)i * 4096 * 1024 * 2); S.Wv = (const char*)(p.ws + WS_WIE + (size_t)i * 4096 * 1024 * 2 + (size_t)3584 * 1024 * 2);
              EpiInEven E{(u16*)(p.ws + WS_P), (u16*)(p.ws + WS_G + G_VT), (u16*)(p.ws + WS_G + G_KF), (u16*)(p.ws + WS_G + G_VTS), p.out, i};
              pg8::gemm_phase(lds, S, E, wave_s); if (DUP == 1) { __syncthreads(); pg8::gemm_phase(lds, S, E, wave_s); } }
            gbar(bar, xst, wave_s); if (DUP == 9) gbar(bar, xst, wave_s);
            phase_attn(kargs(), i, lds, wave_s);
            if (DUP == 2) { __syncthreads(); phase_attn(kargs(), i, lds, wave_s); }
            gbar(bar, xst, wave_s); if (DUP == 9) gbar(bar, xst, wave_s);
            { const Params p = kargs(); int cbf = cb; asm volatile("" : "+s"(cbf)); pg8::StaticOrder S; S.init(MT, 1024, G, cbf, p.ws + WS_H, p.ws + WS_WOE + (size_t)i * 1024 * 1024 * 2); EpiOut E{(u16*)(p.ws + WS_P)}; pg8::gemm_phase(lds, S, E, wave_s); }
            { int rk, cnt; if (gemm_idle_rank(544, G, cb, rk, cnt)) phase_prep_weights(kargs(), lds, wave_s, 1, i, rk, cnt); }
            gbar(bar, xst, wave_s); if (DUP == 9) gbar(bar, xst, wave_s);
        } else {
            { const Params p = kargs(); int cbf = cb; asm volatile("" : "+s"(cbf)); pg8::StaticOrder S; S.init(MT, 4096, G, cbf, p.ws + WS_H, p.ws + WS_WIO + (size_t)i * 4352 * 1024 * 2); EpiInOdd E{(u16*)(p.ws + WS_P), (float*)(p.ws + WS_GATE)}; pg8::gemm_phase(lds, S, E, wave_s); if (DUP == 4) { __syncthreads(); pg8::gemm_phase(lds, S, E, wave_s); } }
            { int rk, cnt; if (gemm_idle_rank(2176, G, cb, rk, cnt)) { phase_gate_logits(kargs(), i, wave_s, rk, cnt); if (layer == 1) phase_prep_weights(kargs(), lds, wave_s, 0, 1, rk, cnt); } }
            gbar(bar, xst, wave_s); if (DUP == 9) gbar(bar, xst, wave_s);
            if (DBG_STOP == 10) { const Params p = kargs(); dbg_dump_u16(kargs(), (const u16*)(p.ws + WS_P), (size_t)47000000, 3, 0, wave_s); dbg_dump_f32(kargs(), (const float*)(p.ws + WS_GATE), (size_t)MT * 16, 48000000, wave_s); return; }
#pragma unroll 1
            for (int pass = 0; pass < 4; ++pass) {
                phase_gdn_pre(kargs(), i, pass, lds, wave_s);
                if (DUP == 5) { __syncthreads(); phase_gdn_pre(kargs(), i, pass, lds, wave_s); }
                if (DUP == 11) { __syncthreads(); phase_gdn_pre(kargs(), i, pass, lds, wave_s, true); }
                gbar(bar, xst, wave_s); if (DUP == 9) gbar(bar, xst, wave_s);
                if (DBG_STOP == 11) { const Params p = kargs(); dbg_dump_u16(kargs(), (const u16*)(p.ws + WS_G), (size_t)1280 * SLOT / 2, 1, 0, wave_s); return; }
                if (SCAN_FH) phase_gdn_scan_fh(kargs(), i, pass, lds, wave_s); else phase_gdn_scan(kargs(), i, pass, lds, wave_s);
                if (DUP == 6) { __syncthreads(); phase_gdn_scan(kargs(), i, pass, lds, wave_s); }
                gbar(bar, xst, wave_s); if (DUP == 9) gbar(bar, xst, wave_s);
                if (DBG_STOP == 12) { const Params p = kargs(); dbg_dump_u16(kargs(), (const u16*)(p.ws + WS_H), (size_t)MT * 1024, 1, 0, wave_s); dbg_dump_f32(kargs(), (const float*)(p.ws + WS_SS), (size_t)256 * 8192, 40000000, wave_s); return; }
                if (DBG_STOP == 13) { const Params p = kargs(); dbg_dump_f32(kargs(), (const float*)(p.ws + WS_SS), (size_t)256 * 8192, 40000000, wave_s); return; }
            }
            if (!SCAN_FH) { phase_gdn_gate(kargs(), i, wave_s);
            gbar(bar, xst, wave_s); } if (DUP == 9) gbar(bar, xst, wave_s);
            { const Params p = kargs(); int cbf = cb; asm volatile("" : "+s"(cbf)); pg8::StaticOrder S; S.init(MT, 1024, G, cbf, p.ws + WS_H, p.ws + WS_WOO + (size_t)i * 1024 * 1024 * 2); EpiOut E{(u16*)(p.ws + WS_P)}; pg8::gemm_phase(lds, S, E, wave_s); }
            if (layer == 1) { int rk, cnt; if (gemm_idle_rank(544, G, cb, rk, cnt)) phase_prep_cache(kargs(), 1, lds, wave_s, rk, cnt); }
            gbar(bar, xst, wave_s); if (DUP == 9) gbar(bar, xst, wave_s);
        }
        { const Params p = kargs(); phase_norm(p, layer == 0, (const u16*)(p.ws + WS_P), p.in[8] + layer * 1024, layer < 3 ? p.in[7] + (layer + 1) * 1024 : nullptr, layer < 3 ? 1 : 2, wave_s); }
        if (layer == DBG_STOP) return;
        if (layer < 3) gbar(bar, xst, wave_s); if (DUP == 9) gbar(bar, xst, wave_s);
    }
}

extern "C" void kernel_launch(void* const* d_in, const int* in_sizes, int n_in, void* d_out, int out_size, void* d_ws, size_t ws_size, hipStream_t stream) {
    static int grid = 0;
    if (grid == 0) {
        if (n_in != 19 || ws_size < WS_END) { fprintf(stderr, "kernel_launch: unexpected n_in %d or workspace %zu < %zu\n", n_in, ws_size, (size_t)WS_END); grid = -1; return; }
        int dev = 0, cus = 0, per_cu = 0;
        if (hipGetDevice(&dev) != hipSuccess || hipDeviceGetAttribute(&cus, hipDeviceAttributeMultiprocessorCount, dev) != hipSuccess) { grid = -1; return; }
        if (hipFuncSetAttribute((const void*)mega_fwd, hipFuncAttributeMaxDynamicSharedMemorySize, LDS_BYTES) != hipSuccess) { fprintf(stderr, "kernel_launch: hipFuncSetAttribute failed\n"); grid = -1; return; }
        if (hipOccupancyMaxActiveBlocksPerMultiprocessor(&per_cu, (const void*)mega_fwd, 512, LDS_BYTES) != hipSuccess || per_cu < 1) { fprintf(stderr, "kernel_launch: occupancy query says %d blocks/CU\n", per_cu); grid = -1; return; }
        grid = cus;
    }
    if (grid < 0) return;
    Params p{};
    for (int k = 0; k < 19; ++k) p.in[k] = (const float*)d_in[k];
    p.out = (float*)d_out; p.ws = (unsigned char*)d_ws;
    void* args[] = {&p};
    hipError_t e = hipLaunchCooperativeKernel((const void*)mega_fwd, dim3(grid), dim3(512), args, LDS_BYTES, stream);
    if (e != hipSuccess) fprintf(stderr, "cooperative launch failed: %s (grid %d)\n", hipGetErrorString(e), grid);
}
```

```cpp
#include <hip/hip_runtime.h>
#include <hip/hip_cooperative_groups.h>
#include <cstdio>
namespace cg = cooperative_groups;

#define LAS __attribute__((address_space(3)))
typedef unsigned short u16;
typedef short bf16x8 __attribute__((ext_vector_type(8)));
typedef float f32x4 __attribute__((ext_vector_type(4)));
typedef unsigned u32x4 __attribute__((ext_vector_type(4)));
typedef unsigned u32x2 __attribute__((ext_vector_type(2)));

constexpr int MP = 32768, MS = 2048, MT = MP + MS;
constexpr int LDS_BYTES = 155648;
#ifndef SCAN_FH
#define SCAN_FH 0
#endif
#ifndef DUP
#define DUP 0
#endif
#ifndef DBG_STOP
#define DBG_STOP 99
#endif
constexpr size_t O_YP = 0, O_YS = 33554432, O_CAP = O_YS + 2097152, O_KBP = O_CAP + 32768, O_VBP = O_KBP + 8388608, O_CCP = O_VBP + 8388608,
                 O_SCP = O_CCP + 294912, O_CAS = O_SCP + 4194304, O_KBS = O_CAS + 65536, O_VBS = O_KBS + 2097152, O_CCS = O_VBS + 2097152, O_SCS = O_CCS + 589824;
constexpr size_t SLOT = 73984;
constexpr size_t WS_WIE = 0;
constexpr size_t WS_WOE = WS_WIE + (size_t)2 * 4096 * 1024 * 2;
constexpr size_t WS_WIO = WS_WOE + (size_t)2 * 1024 * 1024 * 2;
constexpr size_t WS_WOO = WS_WIO + (size_t)2 * 4352 * 1024 * 2;
constexpr size_t WS_H   = WS_WOO + (size_t)2 * 1024 * 1024 * 2;
constexpr size_t WS_P   = WS_H + (size_t)MT * 1024 * 2;
constexpr size_t WS_G   = WS_P + (size_t)MT * 4096 * 2;
constexpr size_t WS_GATE= WS_G + (size_t)1280 * SLOT;
constexpr size_t WS_SS  = WS_GATE + (size_t)MT * 16 * 4;
constexpr size_t WS_BAR = WS_SS + (size_t)512 * 32768;
constexpr size_t WS_END = WS_BAR + 16384;
constexpr size_t G_VT = 0, G_KF = (size_t)16 * 512 * 2048 * 2, G_VTS = G_KF + (size_t)32 * 576 * 512 * 2;

struct Params { const float* in[19]; float* out; unsigned char* ws; };

typedef float f32x2_t __attribute__((ext_vector_type(2)));
typedef __bf16 bf16x2_t __attribute__((ext_vector_type(2)));
__device__ __forceinline__ unsigned cvt_pk_bf16(float lo, float hi) { const f32x2_t v = {lo, hi}; const bf16x2_t b = __builtin_convertvector(v, bf16x2_t); return __builtin_bit_cast(unsigned, b); }
__device__ __forceinline__ float bflo(unsigned w) { return __uint_as_float(w << 16); }
__device__ __forceinline__ float bfhi(unsigned w) { return __uint_as_float(w & 0xffff0000u); }
__device__ __forceinline__ float bf2f(u16 h) { return __uint_as_float(((unsigned)h) << 16); }
__device__ __forceinline__ float silu_f(float x) { return x * __builtin_amdgcn_rcpf(1.0f + __builtin_amdgcn_exp2f(-1.4426950408889634f * x)); }
__device__ __forceinline__ u32x2 pack4(f32x4 v) { u32x2 r; r.x = cvt_pk_bf16(v[0], v[1]); r.y = cvt_pk_bf16(v[2], v[3]); return r; }
__device__ __forceinline__ u32x4 pack8(f32x4 a, f32x4 b) { u32x4 r; r.x = cvt_pk_bf16(a[0], a[1]); r.y = cvt_pk_bf16(a[2], a[3]); r.z = cvt_pk_bf16(b[0], b[1]); r.w = cvt_pk_bf16(b[2], b[3]); return r; }
__device__ __forceinline__ bf16x8 as_bf16x8(u32x4 v) { return __builtin_bit_cast(bf16x8, v); }
__device__ __forceinline__ int wave_index() { int w = __builtin_amdgcn_readfirstlane((int)(threadIdx.x >> 6)); return w; }
__device__ __forceinline__ int tid_fresh(int wave_s) { int l; asm volatile("v_mbcnt_lo_u32_b32 %0, -1, 0\n\tv_mbcnt_hi_u32_b32 %0, -1, %0" : "=v"(l)); return wave_s * 64 + l; }
__device__ __forceinline__ float shx(float v, int mask, int lane) { return __int_as_float(__builtin_amdgcn_ds_bpermute((lane ^ mask) << 2, __float_as_int(v))); }
__device__ __forceinline__ float shup(float v, int d, int lane) { return __int_as_float(__builtin_amdgcn_ds_bpermute((lane - d) << 2, __float_as_int(v))); }
__device__ __forceinline__ void lds_barrier() { asm volatile("s_waitcnt lgkmcnt(0)" ::: "memory"); __builtin_amdgcn_s_barrier(); asm volatile("" ::: "memory"); }
#define MFMA16(a, b, c) __builtin_amdgcn_mfma_f32_16x16x32_bf16((a), (b), (c), 0, 0, 0)

namespace pg8 {
constexpr int BM = 256, BK = 64, HALF = 128, HTB = HALF * BK * 2, STAGE_BYTES = 8 * HTB, NXCD = 8, WGM = 8;
__device__ __forceinline__ int lds_byte(int r, int c) { const int st = (r >> 4) * 2 + (c >> 5), rr = r & 15, cc = c & 31, ob = rr * 64 + cc * 2; return st * 1024 + (ob ^ (((ob >> 9) & 1) << 5)); }
__device__ __forceinline__ void stage_rc(int b, int& R, int& C) { const int st = b / 1024, sb = b % 1024, swz = sb ^ (((sb >> 9) & 1) << 5); R = (st >> 1) * 16 + swz / 64; C = (st & 1) * 32 + (swz % 64) / 2; }
__device__ __forceinline__ int perm32(int rho) { const int n = rho >> 4, i = rho & 15; return 8 * (i >> 2) + 4 * n + (i & 3); }
struct Unit { int pm, pn, kind; };
constexpr size_t TSTEP = (size_t)256 * 1024 * 2;

struct StaticOrder {
    int nM, nN, nwg, G, c; const char* A; const char* B;
    __device__ void init(int M, int N, int G_, int c_, const void* A_, const void* B_) { nM = M / BM; nN = N / BM; nwg = nM * nN; G = G_; c = c_; A = (const char*)A_; B = (const char*)B_; }
    __device__ __forceinline__ bool map(long L, Unit& u) const {
        if (L >= nwg) return false;
        int wgid = (int)L; { const int q = nwg / NXCD, r = nwg % NXCD, xcd = wgid % NXCD, off = wgid / NXCD; wgid = (xcd < r ? xcd * (q + 1) : r * (q + 1) + (xcd - r) * q) + off; }
        const int nig = WGM * nN, gid = wgid / nig, fm = gid * WGM, gsz = (nM - fm) < WGM ? (nM - fm) : WGM;
        u.pm = fm + ((wgid % nig) % gsz); u.pn = (wgid % nig) / gsz; u.kind = 0; return true;
    }
    __device__ __forceinline__ bool next(int i, Unit& u) const { return map((long)i * G + c, u); }
    __device__ __forceinline__ const char* aptr(const Unit& u) const { return A + (size_t)u.pm * TSTEP; }
    __device__ __forceinline__ const char* bptr(const Unit& u) const { return B + (size_t)u.pn * TSTEP; }
};
struct OrderEven {
    StaticOrder so; const char* Wv;
    __device__ __forceinline__ bool next(int i, Unit& u) const {
        const long L = (long)i * so.G + so.c;
        if (L < so.nwg) return so.map(L, u);
        if (L < so.nwg + 272) { const int v = (int)(L - so.nwg); u.pm = v & 1; u.pn = v >> 1; u.kind = 1; return true; }
        return false;
    }
    __device__ __forceinline__ const char* aptr(const Unit& u) const { return (u.kind ? Wv : so.A) + (size_t)u.pm * TSTEP; }
    __device__ __forceinline__ const char* bptr(const Unit& u) const { return (u.kind ? so.A : so.B) + (size_t)u.pn * TSTEP; }
};

template <class Epi, class Sched>
__device__ __forceinline__ void gemm_phase(LAS unsigned char* lds, const Sched& S, const Epi& E, int wave_s) {
    int widl = wave_s; asm volatile("" : "+s"(widl)); const int tid = tid_fresh(widl), wid = widl, lane = tid & 63, wr = wid >> 2, wc = wid & 3, fr = lane & 15, fq = lane >> 4;
    constexpr int K = 1024, nt = K / BK;
    unsigned voffA[2], voffB[2];
#pragma unroll
    for (int i = 0; i < 2; ++i) { int R, C; stage_rc(tid * 16 + i * 8192, R, C); const int Rb = (R & ~31) + perm32(R & 31);
        voffA[i] = (unsigned)(R * K + C) * 2u; voffB[i] = (unsigned)(Rb * K + C) * 2u; }
    const size_t kstep = (size_t)(BK * 2);
    const size_t hstep = (size_t)HALF * K * 2;
    const unsigned ldsw = (unsigned)wid * 1024u;
    const int aoff = lds_byte(wr * 64 + fr, fq * 8), boff = lds_byte(wc * 32 + fr, fq * 8);
#define PG8_SA(b, h) (((b) * 2 + (h)) * HTB)
#define PG8_SB(b, h) ((4 + (b) * 2 + (h)) * HTB)
#define PG8_STAGE(bufoff, gbase, voff) do { _Pragma("unroll") for (int _i = 0; _i < 2; ++_i) \
        __builtin_amdgcn_global_load_lds((const unsigned*)((const char*)(gbase) + (voff)[_i]), (LAS unsigned*)(lds + (bufoff) + ldsw + _i * 8192), 16, 0, 0); } while (0)
#define PG8_LDA(dst, b, h) do { _Pragma("unroll") for (int m = 0; m < 4; ++m) _Pragma("unroll") for (int k = 0; k < 2; ++k) dst[m][k] = *(const LAS bf16x8*)(lds + PG8_SA(b, h) + aoff + m * 2048 + k * 1024); } while (0)
#define PG8_LDB(dst, b, h) do { _Pragma("unroll") for (int n = 0; n < 2; ++n) _Pragma("unroll") for (int k = 0; k < 2; ++k) dst[n][k] = *(const LAS bf16x8*)(lds + PG8_SB(b, h) + boff + n * 2048 + k * 1024); } while (0)
#define PG8_MMA(ai, bj, At, Bt) do { __builtin_amdgcn_s_setprio(1); _Pragma("unroll") for (int m = 0; m < 4; ++m) _Pragma("unroll") for (int n = 0; n < 2; ++n) _Pragma("unroll") for (int k = 0; k < 2; ++k) \
        acc[ai][bj][m][n] = __builtin_amdgcn_mfma_f32_16x16x32_bf16(Bt[n][k], At[m][k], acc[ai][bj][m][n], 0, 0, 0); __builtin_amdgcn_s_setprio(0); } while (0)
#define PG8_WAIT_V(n) asm volatile("s_waitcnt vmcnt(" #n ")" ::: "memory")
#define PG8_WAIT_L(n) asm volatile("s_waitcnt lgkmcnt(" #n ")" ::: "memory")
#define PG8_BAR __builtin_amdgcn_s_barrier()
#define PG8_SCHED __builtin_amdgcn_sched_barrier(0)
    Unit cur, nxt; int ui = 0;
    (void)S.next(0, cur);
    f32x4 acc[2][2][4][2];
#pragma unroll
    for (int a = 0; a < 2; ++a)
#pragma unroll
        for (int b = 0; b < 2; ++b)
#pragma unroll
            for (int m = 0; m < 4; ++m)
#pragma unroll
                for (int n = 0; n < 2; ++n) acc[a][b][m][n] = (f32x4){0.f, 0.f, 0.f, 0.f};
    bf16x8 At[4][2], B0[2][2], B1[2][2];
    const char* cA = S.aptr(cur); const char* cB = S.bptr(cur);
    PG8_STAGE(PG8_SB(0, 0), cB, voffB); PG8_STAGE(PG8_SA(0, 0), cA, voffA); PG8_STAGE(PG8_SB(0, 1), cB + hstep, voffB); PG8_STAGE(PG8_SA(0, 1), cA + hstep, voffA);
    if (wr == 1) PG8_BAR;
    PG8_WAIT_V(4); PG8_BAR;
    PG8_STAGE(PG8_SB(1, 0), cB + kstep, voffB); PG8_STAGE(PG8_SA(1, 0), cA + kstep, voffA); PG8_STAGE(PG8_SB(1, 1), cB + hstep + kstep, voffB);
    PG8_WAIT_V(6); PG8_BAR;
    for (;;) {
        const bool has_next = S.next(ui + 1, nxt);
        const char* nA = has_next ? S.aptr(nxt) : cA; const char* nB = has_next ? S.bptr(nxt) : cB;
        for (int t = 0; t < nt; t += 2) {
            const bool last = (t == nt - 2);
            const char* a1 = cA + (size_t)(t + 1) * kstep;
            const char* a2 = last ? nA : cA + (size_t)(t + 2) * kstep; const char* b2 = last ? nB : cB + (size_t)(t + 2) * kstep;
            const char* a3 = a2 + kstep; const char* b3 = b2 + kstep;
            PG8_LDB(B0, 0, 0); PG8_SCHED; PG8_LDA(At, 0, 0); PG8_STAGE(PG8_SA(1, 1), a1 + hstep, voffA);
            PG8_WAIT_L(8); PG8_BAR; PG8_WAIT_L(0); PG8_MMA(0, 0, At, B0); PG8_BAR; PG8_SCHED;
            PG8_LDB(B1, 0, 1); PG8_STAGE(PG8_SB(0, 0), b2, voffB);
            PG8_BAR; PG8_WAIT_L(0); PG8_MMA(0, 1, At, B1); PG8_BAR;
            PG8_LDA(At, 0, 1); PG8_STAGE(PG8_SA(0, 0), a2, voffA);
            PG8_BAR; PG8_WAIT_L(0); PG8_MMA(1, 0, At, B0); PG8_BAR; PG8_SCHED;
            PG8_STAGE(PG8_SB(0, 1), b2 + hstep, voffB);
            PG8_WAIT_V(6); PG8_BAR; PG8_MMA(1, 1, At, B1); PG8_BAR;
            PG8_LDB(B0, 1, 0); PG8_SCHED; PG8_LDA(At, 1, 0); PG8_STAGE(PG8_SA(0, 1), a2 + hstep, voffA);
            PG8_WAIT_L(8); PG8_BAR; PG8_WAIT_L(0); PG8_MMA(0, 0, At, B0); PG8_BAR; PG8_SCHED;
            PG8_LDB(B1, 1, 1); PG8_STAGE(PG8_SB(1, 0), b3, voffB);
            PG8_BAR; PG8_WAIT_L(0); PG8_MMA(0, 1, At, B1); PG8_BAR;
            PG8_LDA(At, 1, 1); PG8_STAGE(PG8_SA(1, 0), a3, voffA);
            PG8_BAR; PG8_WAIT_L(0); PG8_MMA(1, 0, At, B0); PG8_BAR; PG8_SCHED;
            PG8_STAGE(PG8_SB(1, 1), b3 + hstep, voffB);
            PG8_WAIT_V(6); PG8_BAR; PG8_MMA(1, 1, At, B1); PG8_BAR;
        }
        E(acc, cur, wr, wc, fr, fq);
        if (!has_next) break;
#pragma unroll
        for (int a = 0; a < 2; ++a)
#pragma unroll
            for (int b = 0; b < 2; ++b)
#pragma unroll
                for (int m = 0; m < 4; ++m)
#pragma unroll
                    for (int n = 0; n < 2; ++n) acc[a][b][m][n] = (f32x4){0.f, 0.f, 0.f, 0.f};
        cur = nxt; cA = nA; cB = nB; ++ui;
    }
    PG8_WAIT_V(0);
    if (wr == 0) PG8_BAR;
    PG8_BAR;
#undef PG8_SA
#undef PG8_SB
#undef PG8_STAGE
#undef PG8_LDA
#undef PG8_LDB
#undef PG8_MMA
#undef PG8_WAIT_V
#undef PG8_WAIT_L
#undef PG8_BAR
#undef PG8_SCHED
}
}

struct EpiInEven {
    u16* P; u16* VT; u16* KF; u16* VTS; float* out; int i;
    __device__ __forceinline__ void operator()(const f32x4 (&acc)[2][2][4][2], const pg8::Unit& u, int wr, int wc, int fr, int fq) const {
        if (u.kind == 0) {
            const int row0 = u.pm * 256 + wr * 64 + fr, colb = u.pn * 256 + wc * 32 + 8 * fq;
            const bool isk = (u.pn == 10) || (u.pn == 11);
#pragma unroll
            for (int ai = 0; ai < 2; ++ai)
#pragma unroll
                for (int m = 0; m < 4; ++m) {
                    const int row = row0 + ai * 128 + m * 16;
#pragma unroll
                    for (int bj = 0; bj < 2; ++bj) {
                        const int col = colb + bj * 128; const f32x4 v0 = acc[ai][bj][m][0], v1 = acc[ai][bj][m][1];
                        const u32x4 w = pack8(v0, v1);
                        if (u.pn < 4) { *(u32x2*)(P + (size_t)row * 4096 + ((col >> 3) << 2)) = pack4(v0 * v1); }
                        else if (u.pn < 8) { f32x4 gg; gg[0] = v0[0] * silu_f(v1[0]); gg[1] = v0[1] * silu_f(v1[1]); gg[2] = v0[2] * silu_f(v1[2]); gg[3] = v0[3] * silu_f(v1[3]);
                            *(u32x2*)(P + (size_t)row * 4096 + 512 + (((col - 1024) >> 3) << 2)) = pack4(gg); }
                        else *(u32x4*)(P + (size_t)row * 4096 + col) = w;
                        if (isk) {
                            const int kc = col - 2560;
                            if (row < MP) { const int b = row >> 11, t = row & 2047;
                                if (t >= 1536) { float* d = out + O_KBP + ((size_t)(i * 16 + b) * 512 + (t - 1536)) * 512 + kc; *(f32x4*)d = v0; *(f32x4*)(d + 4) = v1; } }
                            else { const int sb = (row - MP) >> 6, t = row & 63;
                                float* d = out + O_KBS + ((size_t)(i * 32 + sb) * 64 + t) * 512 + kc; *(f32x4*)d = v0; *(f32x4*)(d + 4) = v1;
                                *(u32x4*)(KF + ((size_t)sb * 576 + 512 + t) * 512 + kc) = w; }
                        }
                    }
                }
        } else {
            const int d0 = u.pm * 256 + wr * 64 + fr, tokb = u.pn * 256 + wc * 32 + 8 * fq;
#pragma unroll
            for (int ai = 0; ai < 2; ++ai)
#pragma unroll
                for (int m = 0; m < 4; ++m) {
                    const int dd = d0 + ai * 128 + m * 16;
#pragma unroll
                    for (int bj = 0; bj < 2; ++bj) {
                        const int tok = tokb + bj * 128; const f32x4 v0 = acc[ai][bj][m][0], v1 = acc[ai][bj][m][1];
                        const u32x4 w = pack8(v0, v1);
                        if (tok < MP) { const int b = tok >> 11, t = tok & 2047;
                            *(u32x4*)(VT + ((size_t)b * 512 + dd) * 2048 + t) = w;
                            if (t >= 1536) { float* d = out + O_VBP + ((size_t)(i * 16 + b) * 512 + (t - 1536)) * 512 + dd;
                                d[0] = v0[0]; d[512] = v0[1]; d[1024] = v0[2]; d[1536] = v0[3]; d[2048] = v1[0]; d[2560] = v1[1]; d[3072] = v1[2]; d[3584] = v1[3]; } }
                        else { const int sb = (tok - MP) >> 6, t = tok & 63;
                            *(u32x4*)(VTS + ((size_t)sb * 512 + dd) * 576 + 512 + t) = w;
                            float* d = out + O_VBS + ((size_t)(i * 32 + sb) * 64 + t) * 512 + dd;
                            d[0] = v0[0]; d[512] = v0[1]; d[1024] = v0[2]; d[1536] = v0[3]; d[2048] = v1[0]; d[2560] = v1[1]; d[3072] = v1[2]; d[3584] = v1[3]; }
                    }
                }
        }
    }
};
struct EpiInOdd {
    u16* P; float* GATE;
    __device__ __forceinline__ void operator()(const f32x4 (&acc)[2][2][4][2], const pg8::Unit& u, int wr, int wc, int fr, int fq) const {
        const int row0 = u.pm * 256 + wr * 64 + fr, colb = u.pn * 256 + wc * 32 + 8 * fq;
        if (u.pn < 16) {
#pragma unroll
            for (int ai = 0; ai < 2; ++ai)
#pragma unroll
                for (int m = 0; m < 4; ++m) {
                    const int row = row0 + ai * 128 + m * 16;
#pragma unroll
                    for (int bj = 0; bj < 2; ++bj) *(u32x4*)(P + (size_t)row * 4096 + colb + bj * 128) = pack8(acc[ai][bj][m][0], acc[ai][bj][m][1]);
                }
        } else if (wc == 0 && fq < 2) {
#pragma unroll
            for (int ai = 0; ai < 2; ++ai)
#pragma unroll
                for (int m = 0; m < 4; ++m) {
                    const int row = row0 + ai * 128 + m * 16; float* d = GATE + (size_t)row * 16 + 8 * fq;
                    *(f32x4*)d = acc[ai][0][m][0]; *(f32x4*)(d + 4) = acc[ai][0][m][1];
                }
        }
    }
};
struct EpiOut {
    u16* O;
    __device__ __forceinline__ void operator()(const f32x4 (&acc)[2][2][4][2], const pg8::Unit& u, int wr, int wc, int fr, int fq) const {
        const int row0 = u.pm * 256 + wr * 64 + fr, colb = u.pn * 256 + wc * 32 + 8 * fq;
#pragma unroll
        for (int ai = 0; ai < 2; ++ai)
#pragma unroll
            for (int m = 0; m < 4; ++m) {
                const int row = row0 + ai * 128 + m * 16;
#pragma unroll
                for (int bj = 0; bj < 2; ++bj) *(u32x4*)(O + (size_t)row * 1024 + colb + bj * 128) = pack8(acc[ai][bj][m][0], acc[ai][bj][m][1]);
            }
    }
};

__device__ __forceinline__ void transpose_tile(const float* src, size_t sld, int cvalid, u16* dst, size_t dld, LAS float* t, int tid, const float* src2 = nullptr) {
    { const int r = tid >> 4, c4 = (tid & 15) * 4; const float* sp = src2 ? (((c4 & 4) ? src2 : src) + (c4 >> 3) * 4) : src + c4;
#pragma unroll
      for (int e = 0; e < 2; ++e) { const int rr = r + 32 * e; f32x4 v = (f32x4){0.f, 0.f, 0.f, 0.f};
          if (c4 < cvalid) v = *(const f32x4*)(sp + (size_t)rr * sld);
          t[rr * 65 + c4] = v[0]; t[rr * 65 + c4 + 1] = v[1]; t[rr * 65 + c4 + 2] = v[2]; t[rr * 65 + c4 + 3] = v[3]; } }
    lds_barrier();
    { const int c = tid >> 3, r8 = (tid & 7) * 8; float v[8];
#pragma unroll
      for (int e = 0; e < 8; ++e) v[e] = t[(r8 + e) * 65 + c];
      u32x4 w; w.x = cvt_pk_bf16(v[0], v[1]); w.y = cvt_pk_bf16(v[2], v[3]); w.z = cvt_pk_bf16(v[4], v[5]); w.w = cvt_pk_bf16(v[6], v[7]);
      *(u32x4*)(dst + (size_t)c * dld + r8) = w; }
    lds_barrier();
}

__device__ void phase_prep_weights(const Params& p, LAS unsigned char* lds, int wave_s, int odd, int i_sel, int rank, int count) {
    const int tid = tid_fresh(wave_s); LAS float* t = (LAS float*)lds;
    const int ntile = odd ? 1344 : 1280;
    for (int tt = rank; tt < ntile; tt += count) {
        const int it = odd ? (tt < 1088 ? 2560 + i_sel * 1088 + tt : 4736 + i_sel * 256 + (tt - 1088)) : (tt < 1024 ? i_sel * 1024 + tt : 2048 + i_sel * 256 + (tt - 1024));
        int x = it; const float* src; size_t sld; int cvalid = 64; u16* dst;
        const float* src2 = nullptr;
        if (x < 2048) { const int i = x >> 10, r = x & 1023, nb = r >> 4, kb = r & 15, n0 = nb * 64; const int on = n0 < 3072 ? n0 : (n0 < 3584 ? n0 + 512 : n0 - 512);
            src = p.in[9] + (size_t)i * 1024 * 4096 + (size_t)(kb * 64) * 4096 + on; sld = 4096;
            if (n0 < 2048) { const float* wb = p.in[9] + (size_t)i * 1024 * 4096 + (size_t)(kb * 64) * 4096; const int m0 = n0 & 1023, cho = (m0 >> 3) * 4;
                if (n0 < 1024) { src = wb + 512 + cho; src2 = wb + 1024 + cho; } else { src = wb + cho; src2 = wb + 1536 + cho; } }
            dst = (u16*)(p.ws + WS_WIE) + (size_t)i * 4096 * 1024 + (size_t)n0 * 1024 + kb * 64; }
        else if (x < 2560) { x -= 2048; const int i = x >> 8, r = x & 255, nb = r >> 4, kb = r & 15;
            src = p.in[12] + (size_t)i * 1024 * 1024 + (size_t)(kb * 64) * 1024 + nb * 64; sld = 1024;
            dst = (u16*)(p.ws + WS_WOE) + (size_t)i * 1024 * 1024 + (size_t)(nb * 64) * 1024 + kb * 64; }
        else if (x < 4736) { x -= 2560; const int i = x / 1088, r = x % 1088, nb = r >> 4, kb = r & 15, n0 = nb * 64;
            cvalid = 4112 - n0; cvalid = cvalid > 64 ? 64 : (cvalid < 0 ? 0 : cvalid);
            src = p.in[13] + (size_t)i * 1024 * 4112 + (size_t)(kb * 64) * 4112 + n0; sld = 4112;
            dst = (u16*)(p.ws + WS_WIO) + (size_t)i * 4352 * 1024 + (size_t)n0 * 1024 + kb * 64; }
        else { x -= 4736; const int i = x >> 8, r = x & 255, nb = r >> 4, kb = r & 15;
            src = p.in[18] + (size_t)i * 1024 * 1024 + (size_t)(kb * 64) * 1024 + nb * 64; sld = 1024;
            dst = (u16*)(p.ws + WS_WOO) + (size_t)i * 1024 * 1024 + (size_t)(nb * 64) * 1024 + kb * 64; }
        transpose_tile(src, sld, cvalid, dst, 1024, t, tid, src2);
    }
}
__device__ void phase_prep_cache(const Params& p, int i, LAS unsigned char* lds, int wave_s, int rank, int count) {
    const int tid = tid_fresh(wave_s); LAS float* t = (LAS float*)lds;
    u16* KF = (u16*)(p.ws + WS_G + G_KF); u16* VTS = (u16*)(p.ws + WS_G + G_VTS);
    const float* ck = p.in[3] + (size_t)i * 32 * 512 * 512; const float* cv = p.in[4] + (size_t)i * 32 * 512 * 512;
    for (int it = rank; it < 2048; it += count) {
        const int b = it >> 6, h = (it >> 3) & 7, jt = it & 7;
        transpose_tile(cv + ((size_t)b * 512 + jt * 64) * 512 + h * 64, 512, 64, VTS + ((size_t)b * 512 + h * 64) * 576 + jt * 64, 576, t, tid);
    }
    for (size_t e = ((size_t)rank * 512 + tid) * 4; e < (size_t)32 * 512 * 512; e += (size_t)count * 512 * 4) {
        const f32x4 v = *(const f32x4*)(ck + e); const size_t b = e >> 18, rem = e & 262143;
        *(u32x2*)(KF + b * 576 * 512 + rem) = pack4(v);
    }
}

__device__ void phase_norm(const Params& p, bool from_inputs, const u16* o, const float* gpost, const float* gpre, int dst_mode, int wave_s) {
    const int tidn = tid_fresh(wave_s); const int lane = tidn & 63, wv = tidn >> 6;
    u16* H = (u16*)(p.ws + WS_H);
    const int stride = gridDim.x * 8;
    for (int row0 = blockIdx.x * 8 + wv; row0 < MT; row0 += 2 * stride) {
        const int rows[2] = {row0, row0 + stride};
        f32x4 x[2][4]; f32x4 ov[2][4];
#pragma unroll
        for (int u = 0; u < 2; ++u) { const int row = rows[u]; if (row < MT) {
            if (from_inputs) { const float* xs = row < MP ? p.in[0] + (size_t)row * 1024 : p.in[1] + (size_t)(row - MP) * 1024;
#pragma unroll
                for (int s = 0; s < 4; ++s) x[u][s] = *(const f32x4*)(xs + s * 256 + lane * 4); }
            else { const u16* xb = (const u16*)(p.out + (size_t)row * 1024);
#pragma unroll
                for (int s = 0; s < 4; ++s) { const u32x2 w = *(const u32x2*)(xb + s * 256 + lane * 4); x[u][s] = (f32x4){bflo(w.x), bfhi(w.x), bflo(w.y), bfhi(w.y)}; } }
            if (o) {
#pragma unroll
                for (int s = 0; s < 4; ++s) { const u32x2 w = *(const u32x2*)(o + (size_t)row * 1024 + s * 256 + lane * 4); ov[u][s] = (f32x4){bflo(w.x), bfhi(w.x), bflo(w.y), bfhi(w.y)}; }
            } } }
#pragma unroll
        for (int u = 0; u < 2; ++u) { const int row = rows[u]; if (row < MT) {
            if (o) {
                float ss = 0.f;
#pragma unroll
                for (int s = 0; s < 4; ++s) ss += ov[u][s][0] * ov[u][s][0] + ov[u][s][1] * ov[u][s][1] + ov[u][s][2] * ov[u][s][2] + ov[u][s][3] * ov[u][s][3];
#pragma unroll
                for (int off = 32; off; off >>= 1) ss += shx(ss, off, lane);
                const float rstd = rsqrtf(ss * (1.0f / 1024.0f) + 1e-6f);
#pragma unroll
                for (int s = 0; s < 4; ++s) { const f32x4 g = *(const f32x4*)(gpost + s * 256 + lane * 4); x[u][s] += ov[u][s] * rstd * g; }
            }
            if (dst_mode == 2) {
#pragma unroll
                for (int s = 0; s < 4; ++s) *(f32x4*)(p.out + (size_t)row * 1024 + s * 256 + lane * 4) = x[u][s];
            } else if (dst_mode == 1) { u16* xb = (u16*)(p.out + (size_t)row * 1024);
#pragma unroll
                for (int s = 0; s < 4; ++s) *(u32x2*)(xb + s * 256 + lane * 4) = pack4(x[u][s]);
            }
            if (gpre) {
                float ss = 0.f;
#pragma unroll
                for (int s = 0; s < 4; ++s) ss += x[u][s][0] * x[u][s][0] + x[u][s][1] * x[u][s][1] + x[u][s][2] * x[u][s][2] + x[u][s][3] * x[u][s][3];
#pragma unroll
                for (int off = 32; off; off >>= 1) ss += shx(ss, off, lane);
                const float rstd = rsqrtf(ss * (1.0f / 1024.0f) + 1e-6f);
#pragma unroll
                for (int s = 0; s < 4; ++s) { const f32x4 g = *(const f32x4*)(gpre + s * 256 + lane * 4);
                    *(u32x2*)(H + (size_t)row * 1024 + s * 256 + lane * 4) = pack4(x[u][s] * rstd * g); }
            } } }
    }
}

__device__ __forceinline__ void att_tile(const LAS u16* Kc, const LAS float* bt, float bconst, int jt, int hh, int qi0, int fr, int fq, int lane,
                                         const bf16x8 (&qf)[2], f32x4 (&oacc)[4], float& mrun, float& lsum) {
    const LAS u16* Vc = Kc + 9216;
            f32x4 s[4];
#pragma unroll
            for (int kt = 0; kt < 4; ++kt) { s[kt] = (f32x4){0.f, 0.f, 0.f, 0.f};
#pragma unroll
                for (int ks = 0; ks < 2; ++ks) { const bf16x8 a = *(const LAS bf16x8*)(Kc + (hh * 64 + kt * 16 + fr) * 72 + ks * 32 + fq * 8); s[kt] = MFMA16(a, qf[ks], s[kt]); } }
            const int qi = qi0 + fr; float mx = -1e30f;
            if (jt <= 3) {
#pragma unroll
                for (int kt = 0; kt < 4; ++kt)
#pragma unroll
                    for (int r = 0; r < 4; ++r) { const float v = s[kt][r] * 0.18033688011112042f + bconst; s[kt][r] = v; mx = fmaxf(mx, v); }
            } else if (jt == 4) {
#pragma unroll
                for (int kt = 0; kt < 4; ++kt)
#pragma unroll
                    for (int r = 0; r < 4; ++r) { const int j = 64 * jt + kt * 16 + 4 * fq + r; int idx = qi - j + 768; idx = idx > 512 ? 512 : idx;
                        const float v = s[kt][r] * 0.18033688011112042f + bt[hh * 513 + idx]; s[kt][r] = v; mx = fmaxf(mx, v); }
            } else {
                const LAS float* bb = bt + hh * 513 + (qi - 64 * jt - 4 * fq + 768);
#pragma unroll
                for (int kt = 0; kt < 4; ++kt)
#pragma unroll
                    for (int r = 0; r < 4; ++r) { const float v = s[kt][r] * 0.18033688011112042f + bb[-(kt * 16 + r)]; s[kt][r] = v; mx = fmaxf(mx, v); }
            }
            mx = fmaxf(mx, shx(mx, 16, lane)); mx = fmaxf(mx, shx(mx, 32, lane));
            if (__any(mx > mrun)) {
                const float mnew = fmaxf(mrun, mx), alpha = __builtin_amdgcn_exp2f(mrun - mnew); mrun = mnew;
                lsum *= alpha;
#pragma unroll
                for (int dt = 0; dt < 4; ++dt) oacc[dt] *= alpha;
            }
            float ps = 0.f;
#pragma unroll
            for (int kt = 0; kt < 4; ++kt)
#pragma unroll
                for (int r = 0; r < 4; ++r) { const float pv = __builtin_amdgcn_exp2f(s[kt][r] - mrun); s[kt][r] = pv; ps += pv; }
            lsum += ps;
#pragma unroll
            for (int ks2 = 0; ks2 < 2; ++ks2) { const bf16x8 pb = as_bf16x8(pack8(s[2 * ks2], s[2 * ks2 + 1]));
#pragma unroll
                for (int dt = 0; dt < 4; ++dt) { const LAS u16* vr = Vc + (hh * 64 + dt * 16 + fr) * 72 + ks2 * 32 + 4 * fq;
                    const u32x2 lo = *(const LAS u32x2*)vr, hi = *(const LAS u32x2*)(vr + 16);
                    u32x4 va; va.x = lo.x; va.y = lo.y; va.z = hi.x; va.w = hi.y;
                    oacc[dt] = MFMA16(as_bf16x8(va), pb, oacc[dt]); } }
}

__device__ void phase_attn(const Params& p, int i, LAS unsigned char* lds, int wave_s) {
    const int tid = tid_fresh(wave_s), w = wave_s, lane = tid & 63, fr = lane & 15, fq = lane >> 4, hh = w >> 2, qi0 = (w & 3) * 16;
    const u16* P = (const u16*)(p.ws + WS_P); u16* YM = (u16*)(p.ws + WS_H);
    const u16* VT = (const u16*)(p.ws + WS_G + G_VT); const u16* KF = (const u16*)(p.ws + WS_G + G_KF); const u16* VTS = (const u16*)(p.ws + WS_G + G_VTS);
    LAS u16* Ks = (LAS u16*)lds;
    LAS float* bt = (LAS float*)(lds + 73728);
    const float* convw = p.in[10] + (size_t)i * 3 * 512; const float* relb = p.in[11] + (size_t)i * 8 * 513;
    const bool xmap = false; const int bx = blockIdx.x & 7, bs = blockIdx.x >> 3;
    const int nmine = xmap ? (bs < 8 ? 10 : 8) : (2176 - (int)blockIdx.x + (int)gridDim.x - 1) / (int)gridDim.x;
    int hp_loaded = -1;
    for (int iq = 0; iq < nmine; ++iq) {
        int cid, hp;
        if (xmap) { if (iq < 8) { const int g = bx * 8 + iq; cid = (g >> 2) * 32 + bs; hp = g & 3; } else { const int j = bx + 8 * (2 * bs + (iq - 8)); cid = 512 + (j >> 2); hp = j & 3; } }
        else if (gridDim.x == 256) {
            const int idx = blockIdx.x + iq * 256; hp = idx & 3;
            if (idx < 128) cid = 512 + (idx >> 2);
            else if (idx < 1664) { const int r = (idx - 128) >> 2; cid = (r / 24) * 32 + 8 + (r % 24); }
            else { const int j = idx - 1664, g = j >> 6, seq = (j & 63) >> 2; const int cm = (0x10542367 >> (4 * g)) & 15; cid = seq * 32 + cm; }
        }
        else { const int it = blockIdx.x + iq * gridDim.x; cid = it >> 2; hp = it & 3;
            if (cid < 512) cid = (cid & ~31) | (((cid & 31) + 5 * (cid >> 5)) & 31); }
        const bool samp = cid >= 512; const int b = samp ? cid - 512 : (cid >> 5); const int c = samp ? 0 : (cid & 31);
        const long rowbase = (long)cid * 64;
        if (hp != hp_loaded) {
            lds_barrier();
            for (int x = tid; x < 1026; x += 512) { const int h2 = x >= 513 ? 1 : 0; bt[x] = relb[(2 * hp + h2) * 513 + (x - 513 * h2)] * 1.4426950408889634f; }
            hp_loaded = hp;
        }
        const int h = 2 * hp + hh;
        const u16* Kb; long kst; const u16* Vb; long vst; long tstart; int jt0;
        if (!samp) { Kb = P + (size_t)b * 2048 * 4096 + 2560; kst = 4096; Vb = VT + (size_t)b * 512 * 2048; vst = 2048; tstart = (long)c * 64 - 512; jt0 = c >= 8 ? 0 : 8 - c; }
        else { Kb = KF + (size_t)b * 576 * 512; kst = 512; Vb = VTS + (size_t)b * 512 * 576; vst = 576; tstart = 0; jt0 = 0; }
        bf16x8 qf[2];
        { const u16* qr = P + (rowbase + qi0 + fr) * 4096 + 2048 + h * 64 + fq * 8; qf[0] = *(const bf16x8*)qr; qf[1] = *(const bf16x8*)(qr + 32); }
        const int lkey = tid >> 3, lpart = tid & 7;
        u32x4 kreg[2], vreg[2];
        u32x4 kreg2[2], vreg2[2];
#define ATT_LOAD(kr_, vr_, jt_) do { const long t0_ = tstart + 64 * (jt_); _Pragma("unroll") for (int e = 0; e < 2; ++e) { \
            kr_[e] = *(const u32x4*)(Kb + (t0_ + lkey) * kst + (2 * hp + e) * 64 + lpart * 8); vr_[e] = *(const u32x4*)(Vb + (long)((2 * hp + e) * 64 + lkey) * vst + t0_ + lpart * 8); } } while (0)
#define ATT_STORE(buf_, kr_, vr_) do { _Pragma("unroll") for (int e = 0; e < 2; ++e) { \
            *(LAS u32x4*)(Ks + (buf_) * 18432 + (e * 64 + lkey) * 72 + lpart * 8) = kr_[e]; *(LAS u32x4*)(Ks + (buf_) * 18432 + 9216 + (e * 64 + lkey) * 72 + lpart * 8) = vr_[e]; } } while (0)
        ATT_LOAD(kreg, vreg, jt0);
        const int ya_ch = hp * 128 + (tid & 15) * 8, ya_t0 = (tid >> 4) * 2;
        u32x4 ya_u[4], ya_g[2];
#pragma unroll
        for (int k = 0; k < 4; ++k) { const int t = ya_t0 - 2 + k;
            if (t >= 0 || (!samp && c > 0)) ya_u[k] = *(const u32x4*)(P + (rowbase + t) * 4096 + ya_ch);
            else ya_u[k] = (u32x4){0u, 0u, 0u, 0u}; }
#pragma unroll
        for (int k2 = 0; k2 < 2; ++k2) ya_g[k2] = *(const u32x4*)(P + (rowbase + ya_t0 + k2) * 4096 + 512 + ya_ch);
        f32x4 oacc[4];
#pragma unroll
        for (int dt = 0; dt < 4; ++dt) oacc[dt] = (f32x4){0.f, 0.f, 0.f, 0.f};
        float mrun = -1e30f, lsum = 0.f;
        lds_barrier(); ATT_STORE(0, kreg, vreg); if (jt0 + 1 <= 8) ATT_LOAD(kreg, vreg, jt0 + 1); if (jt0 + 2 <= 8) ATT_LOAD(kreg2, vreg2, jt0 + 2); lds_barrier();
        const float bconst = bt[hh * 513 + 512];
        int cb2 = 0;
        for (int jt = jt0; jt <= 8; jt += 2) {
            if (jt + 1 <= 8) { ATT_STORE(cb2 ^ 1, kreg, vreg); if (jt + 3 <= 8) ATT_LOAD(kreg, vreg, jt + 3); }
            att_tile(Ks + cb2 * 18432, bt, bconst, jt, hh, qi0, fr, fq, lane, qf, oacc, mrun, lsum);
            lds_barrier(); cb2 ^= 1;
            if (jt + 1 <= 8) {
                if (jt + 2 <= 8) { ATT_STORE(cb2 ^ 1, kreg2, vreg2); if (jt + 4 <= 8) ATT_LOAD(kreg2, vreg2, jt + 4); }
                att_tile(Ks + cb2 * 18432, bt, bconst, jt + 1, hh, qi0, fr, fq, lane, qf, oacc, mrun, lsum);
                lds_barrier(); cb2 ^= 1;
            }
        }
#undef ATT_LOAD
#undef ATT_STORE
        lsum += shx(lsum, 16, lane); lsum += shx(lsum, 32, lane);
        const float inv = 1.0f / lsum;
        { const long row = rowbase + qi0 + fr;
#pragma unroll
          for (int dt = 0; dt < 4; ++dt) { const int col = h * 64 + dt * 16 + 4 * fq; const u32x2 bz = *(const u32x2*)(P + row * 4096 + 3072 + col);
              f32x4 y; y[0] = oacc[dt][0] * inv * silu_f(bflo(bz.x)); y[1] = oacc[dt][1] * inv * silu_f(bfhi(bz.x)); y[2] = oacc[dt][2] * inv * silu_f(bflo(bz.y)); y[3] = oacc[dt][3] * inv * silu_f(bfhi(bz.y));
              *(u32x2*)(YM + row * 1024 + 512 + col) = pack4(y); } }
        {
            const int ch = ya_ch, t0 = ya_t0;
            float u[4][8];
#pragma unroll
            for (int k = 0; k < 4; ++k) { const int t = t0 - 2 + k;
                if (t >= 0 || (!samp && c > 0)) {
#pragma unroll
                    for (int e = 0; e < 4; ++e) { u[k][2 * e] = bflo(ya_u[k][e]); u[k][2 * e + 1] = bfhi(ya_u[k][e]); } }
                else if (samp) { const float* hs = p.in[2] + ((size_t)(i * 32 + b) * 2 + (2 + t)) * 512 + ch;
#pragma unroll
                    for (int e = 0; e < 8; ++e) u[k][e] = hs[e]; }
                else {
#pragma unroll
                    for (int e = 0; e < 8; ++e) u[k][e] = 0.f; } }
            float cw[3][8];
#pragma unroll
            for (int j = 0; j < 3; ++j)
#pragma unroll
                for (int e = 0; e < 8; ++e) cw[j][e] = convw[j * 512 + ch + e];
#pragma unroll
            for (int k2 = 0; k2 < 2; ++k2) { const int t = t0 + k2; const u32x4 gv = ya_g[k2];
                float y[8];
#pragma unroll
                for (int e = 0; e < 8; ++e) { const float cvv = cw[0][e] * u[k2][e] + cw[1][e] * u[k2 + 1][e] + cw[2][e] * u[k2 + 2][e];
                    const float gvv = (e & 1) ? bfhi(gv[e >> 1]) : bflo(gv[e >> 1]);
                    y[e] = gvv * cvv; }
                u32x4 wv; wv.x = cvt_pk_bf16(y[0], y[1]); wv.y = cvt_pk_bf16(y[2], y[3]); wv.z = cvt_pk_bf16(y[4], y[5]); wv.w = cvt_pk_bf16(y[6], y[7]);
                *(u32x4*)(YM + (rowbase + t) * 1024 + ch) = wv; }
            if (t0 == 62 && (samp || c == 31)) {
                float* d = samp ? p.out + O_CAS + ((size_t)(i * 32 + b) * 2) * 512 + ch : p.out + O_CAP + ((size_t)(i * 16 + b) * 2) * 512 + ch;
#pragma unroll
                for (int e = 0; e < 8; ++e) { d[e] = u[2][e]; d[512 + e] = u[3][e]; }
            }
        }
    }
}

__device__ void phase_gate_logits(const Params& p, int i, int wave_s, int rank, int count) {
    const int tid = tid_fresh(wave_s), lane = tid & 63, fr = lane & 15, fq = lane >> 4;
    const u16* H = (const u16*)(p.ws + WS_H); const u16* Wg = (const u16*)(p.ws + WS_WIO) + (size_t)i * 4352 * 1024 + (size_t)4096 * 1024; float* GATE = (float*)(p.ws + WS_GATE);
    for (int t = rank * 8 + wave_s; t < MT / 16; t += count * 8) {
        f32x4 acc = (f32x4){0.f, 0.f, 0.f, 0.f};
        const u16* ar = H + (size_t)(t * 16 + fr) * 1024 + fq * 8; const u16* br = Wg + (size_t)fr * 1024 + fq * 8;
#pragma unroll 8
        for (int ks = 0; ks < 32; ++ks) { const bf16x8 a = *(const bf16x8*)(ar + ks * 32); const bf16x8 b = *(const bf16x8*)(br + ks * 32); acc = MFMA16(a, b, acc); }
#pragma unroll
        for (int r = 0; r < 4; ++r) GATE[(size_t)(t * 16 + 4 * fq + r) * 16 + fr] = acc[r];
    }
}

constexpr int HB = 77056;
__device__ void phase_gdn_pre(const Params& p, int i, int pass, LAS unsigned char* lds, int wave_s, bool lite = false) {
    const int tid = tid_fresh(wave_s), half = wave_s >> 2, ht = tid & 255, hw = wave_s & 3, lane = tid & 63, fr = lane & 15, fq = lane >> 4;
    LAS unsigned char* hb = lds + half * HB;
    LAS u16* qn = (LAS u16*)hb; LAS u16* kn = (LAS u16*)(hb + 17408); LAS u16* vb = (LAS u16*)(hb + 34816); LAS float* am = (LAS float*)(hb + 52224); LAS float* tb = (LAS float*)(hb + 69632); LAS float* cwl = (LAS float*)(hb + 70912);
    const u16* P = (const u16*)(p.ws + WS_P); const float* GATE = (const float*)(p.ws + WS_GATE);
    const int nch = pass == 0 ? 1280 : 1024;
    int cw_loaded = -1;
    for (int it = blockIdx.x; it < nch / 2; it += gridDim.x) {
        const int ci = it * 2 + half;
        int h, b, c, slot; bool samp; long rowbase;
        if (ci < 1024) { h = ci & 7; const int cc = (ci >> 3) & 7; b = ci >> 6; c = pass * 8 + cc; slot = (b * 8 + h) * 8 + cc; samp = false; rowbase = (long)b * 2048 + c * 64; }
        else { const int x = ci - 1024; h = x & 7; b = x >> 3; c = 0; slot = 1024 + x; samp = true; rowbase = MP + (long)b * 64; }
        unsigned char* sl = p.ws + WS_G + (size_t)slot * SLOT;
        u16* Wn = (u16*)sl; u16* U0T = (u16*)(sl + 16384); u16* Qg = (u16*)(sl + 32768); u16* Kd = (u16*)(sl + 49152); u16* QK = (u16*)(sl + 65536);
        const bool first = samp || c == 0, lastc = samp || c == 31;
        float gl_b = 0.f, gl_a = 0.f;
        if (hw == 0) { const float* gt = GATE + (size_t)(rowbase + lane) * 16; gl_b = gt[h]; gl_a = gt[8 + h]; }
        u32x4 rc[7], rn[7];
#define PRE_LOADRAW(dst, part_) do { _Pragma("unroll") for (int k = 0; k < 7; ++k) { const int t = (ht >> 4) * 4 - 3 + k; \
            if (t >= 0 || !first) dst[k] = *(const u32x4*)(P + (rowbase + t) * 4096 + (part_) * 1024 + h * 128 + (ht & 15) * 8); else dst[k] = (u32x4){0u, 0u, 0u, 0u}; } } while (0)
        PRE_LOADRAW(rc, 0);
        if ((it & 3) != cw_loaded) {
            lds_barrier();
            for (int x = ht; x < 1536; x += 256) { const int j = x / 384, cch = x % 384; cwl[x] = p.in[14][(size_t)(i * 4 + j) * 3072 + (cch >> 7) * 1024 + h * 128 + (cch & 127)]; }
            cw_loaded = it & 3;
            lds_barrier();
        }
#pragma unroll 1
        for (int part = 0; part < 3; ++part) {
            if (part < 2) PRE_LOADRAW(rn, part + 1);
            const int c8 = (ht & 15) * 8, r0 = (ht >> 4) * 4, chg = part * 1024 + h * 128 + c8;
            float raw[7][8];
#pragma unroll
            for (int k = 0; k < 7; ++k) { const int t = r0 - 3 + k;
                if (t >= 0 || !first) { const u32x4 v = rc[k];
#pragma unroll
                    for (int e = 0; e < 4; ++e) { raw[k][2 * e] = bflo(v[e]); raw[k][2 * e + 1] = bfhi(v[e]); } }
                else if (samp) { const float* s = p.in[5] + ((size_t)(i * 32 + b) * 3 + (3 + t)) * 3072 + chg;
#pragma unroll
                    for (int e = 0; e < 8; ++e) raw[k][e] = s[e]; }
                else {
#pragma unroll
                    for (int e = 0; e < 8; ++e) raw[k][e] = 0.f; } }
            float cw[4][8];
#pragma unroll
            for (int j = 0; j < 4; ++j) { const f32x4 c0 = *(const LAS f32x4*)(cwl + j * 384 + part * 128 + c8), c1 = *(const LAS f32x4*)(cwl + j * 384 + part * 128 + c8 + 4);
#pragma unroll
                for (int e = 0; e < 4; ++e) { cw[j][e] = c0[e]; cw[j][4 + e] = c1[e]; } }
            LAS u16* dstl = part == 0 ? qn : (part == 1 ? kn : vb);
#pragma unroll
            for (int rr = 0; rr < 4; ++rr) { float y[8]; float ss = 0.f;
#pragma unroll
                for (int e = 0; e < 8; ++e) { const float cv = cw[0][e] * raw[rr][e] + cw[1][e] * raw[rr + 1][e] + cw[2][e] * raw[rr + 2][e] + cw[3][e] * raw[rr + 3][e]; y[e] = silu_f(cv); ss += y[e] * y[e]; }
                if (part < 2) { ss += shx(ss, 1, lane); ss += shx(ss, 2, lane); ss += shx(ss, 4, lane); ss += shx(ss, 8, lane);
                    const float sc = rsqrtf(ss + 1e-6f) * (part == 0 ? 0.08838834764831845f : 1.0f);
#pragma unroll
                    for (int e = 0; e < 8; ++e) y[e] *= sc; }
                u32x4 wv; wv.x = cvt_pk_bf16(y[0], y[1]); wv.y = cvt_pk_bf16(y[2], y[3]); wv.z = cvt_pk_bf16(y[4], y[5]); wv.w = cvt_pk_bf16(y[6], y[7]);
                *(LAS u32x4*)(dstl + (r0 + rr) * 136 + c8) = wv; }
            if (lastc && r0 == 60) {
                float* d = samp ? p.out + O_CCS + ((size_t)(i * 32 + b) * 3) * 3072 + chg : p.out + O_CCP + ((size_t)(i * 16 + b) * 3) * 3072 + chg;
#pragma unroll
                for (int k = 0; k < 3; ++k)
#pragma unroll
                    for (int e = 0; e < 8; ++e) d[(size_t)k * 3072 + e] = raw[4 + k][e];
            }
#pragma unroll
            for (int k = 0; k < 7; ++k) rc[k] = rn[k];
        }
        if (hw == 0) { const int l = lane; const float bl = gl_b, al = gl_a;
            const float beta = 1.0f / (1.0f + __expf(-bl)); const float A = __expf(p.in[15][i * 8 + h]); const float xx = al + p.in[16][i * 8 + h];
            const float sp = xx > 20.f ? xx : __logf(1.0f + __expf(xx));   const float g = -A * sp;
            float gc = g;
#pragma unroll
            for (int o = 1; o < 64; o <<= 1) { const float tt = shup(gc, o, lane); if (lane >= o) gc += tt; }
            const float glast = __int_as_float(__builtin_amdgcn_readlane(__float_as_int(gc), 63));
            tb[l] = beta; tb[64 + l] = gc; tb[128 + l] = __expf(gc); tb[192 + l] = __expf(glast - gc); if (l == 0) tb[256] = __expf(glast); }
        lds_barrier();
        { const int lt = half == 0 ? hw : 3 - hw;
#pragma unroll 1
          for (int mt = 0; mt <= lt; ++mt) {
              f32x4 akk = (f32x4){0.f, 0.f, 0.f, 0.f};
#pragma unroll
              for (int ks = 0; ks < 4; ++ks) { const bf16x8 bk = *(const LAS bf16x8*)(kn + (mt * 16 + fr) * 136 + ks * 32 + fq * 8);
                  const bf16x8 ak = *(const LAS bf16x8*)(kn + (lt * 16 + fr) * 136 + ks * 32 + fq * 8); akk = MFMA16(ak, bk, akk); }
#pragma unroll
              for (int r = 0; r < 4; ++r) { const int l = lt * 16 + 4 * fq + r, m = mt * 16 + fr; const float dcy = __expf(tb[64 + l] - tb[64 + m]);
                  am[l * 68 + m] = (m < l) ? tb[l] * akk[r] * dcy : 0.f; }
          } }
        lds_barrier();
        if (!lite) {
        }
        { const bool solver = half == 0 ? ht < 128 : ht >= 128; const int cidx = ht & 127;
        if (solver) { if (!lite) {
          f32x2_t sol[64];
          const unsigned ambase = (unsigned)(unsigned long)am, vbb = (unsigned)(unsigned long)(vb + cidx), knb = (unsigned)(unsigned long)(kn + cidx), tbb = (unsigned)(unsigned long)tb;
#pragma unroll
          for (int l = 0; l < 64; ++l) {
              unsigned ra = ambase + l * 272, va = vbb + l * 272, ka = knb + l * 272, ta = tbb + l * 4;
              if (l >= 2) asm volatile("" : "+v"(ra), "+v"(va), "+v"(ka), "+v"(ta) : "v"(sol[l - 2].x));
              const float beta = *(const LAS float*)(unsigned long)ta, eg = ((const LAS float*)(unsigned long)ta)[128];
              f32x2_t sv; sv.x = bf2f(*(const LAS u16*)(unsigned long)va) * beta; sv.y = bf2f(*(const LAS u16*)(unsigned long)ka) * beta * eg;
              f32x2_t pa[2];
#pragma unroll
              for (int e = 0; e < 2; ++e) pa[e] = (f32x2_t){0.f, 0.f};
#pragma unroll
              for (int m4 = 0; m4 < (l + 3) / 4; ++m4) { const f32x4 a4 = ((const LAS f32x4*)(unsigned long)ra)[m4];
#pragma unroll
                  for (int e = 0; e < 4; ++e) if (4 * m4 + e < l) { const f32x2_t aa = {a4[e], a4[e]}; pa[e & 1] += aa * sol[4 * m4 + e]; } }
              sol[l] = sv - (pa[0] + pa[1]); }
#pragma unroll
          for (int x = 0; x < 8; ++x) { u32x4 wv; wv.x = cvt_pk_bf16(sol[8 * x].x, sol[8 * x + 1].x); wv.y = cvt_pk_bf16(sol[8 * x + 2].x, sol[8 * x + 3].x); wv.z = cvt_pk_bf16(sol[8 * x + 4].x, sol[8 * x + 5].x); wv.w = cvt_pk_bf16(sol[8 * x + 6].x, sol[8 * x + 7].x);
              *(u32x4*)(U0T + cidx * 64 + 8 * x) = wv; }
#pragma unroll
          for (int l = 0; l < 64; ++l) vb[l * 136 + cidx] = (u16)(cvt_pk_bf16(-sol[l].y, 0.f) & 0xffffu);
        } } else {
          { const int l = cidx >> 1, pc = (cidx & 1) * 64; const float eg = tb[128 + l];
#pragma unroll
            for (int x = 0; x < 8; ++x) { const u32x4 v = *(const LAS u32x4*)(qn + l * 136 + pc + x * 8); u32x4 wv;
#pragma unroll
                for (int e = 0; e < 4; ++e) wv[e] = cvt_pk_bf16(bflo(v[e]) * eg, bfhi(v[e]) * eg);
                *(u32x4*)(Qg + l * 128 + pc + x * 8) = wv; } }
          { const int k = cidx;
#pragma unroll
            for (int x = 0; x < 8; ++x) { float y[8];
#pragma unroll
                for (int e = 0; e < 8; ++e) { const int l = x * 8 + e; y[e] = bf2f(kn[l * 136 + k]) * tb[192 + l]; }
                u32x4 wv; wv.x = cvt_pk_bf16(y[0], y[1]); wv.y = cvt_pk_bf16(y[2], y[3]); wv.z = cvt_pk_bf16(y[4], y[5]); wv.w = cvt_pk_bf16(y[6], y[7]);
                *(u32x4*)(Kd + k * 64 + x * 8) = wv; } }
          { const int wsel = cidx >> 6;
#pragma unroll 1
            for (int q2 = 0; q2 < 2; ++q2) { const int lt = wsel == 0 ? (q2 == 0 ? 0 : 3) : (q2 == 0 ? 1 : 2);
#pragma unroll 1
              for (int mt = 0; mt < 4; ++mt) {
                  if (mt <= lt) {
                      f32x4 aqk = (f32x4){0.f, 0.f, 0.f, 0.f};
#pragma unroll
                      for (int ks = 0; ks < 4; ++ks) { const bf16x8 bk = *(const LAS bf16x8*)(kn + (mt * 16 + fr) * 136 + ks * 32 + fq * 8);
                          const bf16x8 aq = *(const LAS bf16x8*)(qn + (lt * 16 + fr) * 136 + ks * 32 + fq * 8); aqk = MFMA16(aq, bk, aqk); }
#pragma unroll
                      for (int r = 0; r < 4; ++r) { const int l = lt * 16 + 4 * fq + r, m = mt * 16 + fr; const float dcy = __expf(tb[64 + l] - tb[64 + m]);
                          const float q = (m <= l) ? aqk[r] * dcy : 0.f; QK[l * 64 + m] = (u16)(cvt_pk_bf16(q, 0.f) & 0xffffu); }
                  } else {
#pragma unroll
                      for (int r = 0; r < 4; ++r) { const int l = lt * 16 + 4 * fq + r, m = mt * 16 + fr; QK[l * 64 + m] = 0; }
                  }
              } } }
        } }
        lds_barrier();
        if (!lite) { const int l = ht >> 2, pc = (ht & 3) * 32;
#pragma unroll
          for (int x = 0; x < 4; ++x) *(u32x4*)(Wn + l * 128 + pc + x * 8) = *(const LAS u32x4*)(vb + l * 136 + pc + x * 8); }
        if (ht == 0) *(float*)(sl + 73728) = tb[256];
        lds_barrier();
    }
}

__device__ void phase_gdn_scan(const Params& p, int i, int pass, LAS unsigned char* lds, int wave_s) {
    const int tid = tid_fresh(wave_s), w = wave_s, lane = tid & 63, fr = lane & 15, fq = lane >> 4;
    LAS u16* St = (LAS u16*)lds;
    LAS u16* uT = (LAS u16*)(lds + 34816);
    u16* ORAW = (u16*)(p.ws + WS_H);
    const int nitems = pass == 0 ? 768 : 256;
    for (int it = blockIdx.x; it < nitems; it += gridDim.x) {
        const bool samp = it >= 256; const int x = samp ? it - 256 : it; const int xb = x & 255;
        const int chain = (xb & 7) + 8 * (xb >> 4) + 128 * (x >> 8), vh = (xb >> 3) & 1, b = chain >> 3, h = chain & 7;
        const int nchunk = samp ? 1 : 8, slot0 = samp ? 1024 + chain : chain * 8;
        const long rowbase0 = samp ? MP + (long)b * 64 : (long)b * 2048 + pass * 512;
        float* ssave_rd = (float*)(p.ws + WS_SS + (size_t)((pass & 1) * 256 + x) * 32768);
        float* ssave_wr = (float*)(p.ws + WS_SS + (size_t)(((pass + 1) & 1) * 256 + x) * 32768);
        f32x4 accS[4];
        const int kt = w;
        if (samp) { const float* s0 = p.in[6] + ((size_t)(i * 32 + b) * 8 + h) * 16384;
#pragma unroll
            for (int vt = 0; vt < 4; ++vt)
#pragma unroll
                for (int r = 0; r < 4; ++r) accS[vt][r] = s0[(kt * 16 + 4 * fq + r) * 128 + vh * 64 + vt * 16 + fr]; }
        else if (pass == 0) {
#pragma unroll
            for (int vt = 0; vt < 4; ++vt) accS[vt] = (f32x4){0.f, 0.f, 0.f, 0.f}; }
        else {
#pragma unroll
            for (int vt = 0; vt < 4; ++vt) accS[vt] = *(const f32x4*)(ssave_rd + ((w * 4 + vt) * 64 + lane) * 4); }
        lds_barrier();
#pragma unroll
        for (int vt = 0; vt < 4; ++vt) *(LAS u32x2*)(St + (vt * 16 + fr) * 136 + kt * 16 + 4 * fq) = pack4(accS[vt]);
        lds_barrier();
        int cur = 0;
        const int lt = w >> 1, vt0 = (w & 1) * 2;
        bf16x8 aW[4], aQ[4], aQK[2], aK[2]; u32x2 aU[2]; float adec = 1.f;
        bf16x8 bW[4], bQ[4], bQK[2], bK[2]; u32x2 bU[2]; float bdec = 1.f;
        bf16x8 cW[4], cQ[4], cQK[2], cK[2]; u32x2 cU[2]; float cdec = 1.f;
#define SCAN_LOAD(W_, Q_, QK_, K_, U_, dec_, slotidx) do { const unsigned char* sl_ = p.ws + WS_G + (size_t)(slotidx) * SLOT; \
            _Pragma("unroll") for (int ks = 0; ks < 4; ++ks) { W_[ks] = *(const bf16x8*)((const u16*)sl_ + (lt * 16 + fr) * 128 + ks * 32 + fq * 8); Q_[ks] = *(const bf16x8*)((const u16*)(sl_ + 32768) + (lt * 16 + fr) * 128 + ks * 32 + fq * 8); } \
            _Pragma("unroll") for (int ks2 = 0; ks2 < 2; ++ks2) { QK_[ks2] = *(const bf16x8*)((const u16*)(sl_ + 65536) + (lt * 16 + fr) * 64 + ks2 * 32 + fq * 8); K_[ks2] = *(const bf16x8*)((const u16*)(sl_ + 49152) + (kt * 16 + fr) * 64 + ks2 * 32 + fq * 8); } \
            _Pragma("unroll") for (int j = 0; j < 2; ++j) U_[j] = *(const u32x2*)((const u16*)(sl_ + 16384) + (vh * 64 + (vt0 + j) * 16 + fr) * 64 + lt * 16 + 4 * fq); \
            dec_ = *(const float*)(sl_ + 73728); } while (0)
#define SCAN_STEP(W_, Q_, QK_, K_, U_, dec_, cc_) do { \
            const long rowbase = rowbase0 + (cc_) * 64; \
            LAS u16* Sc = St + cur * 64 * 136; LAS u16* Sn = St + (cur ^ 1) * 64 * 136; \
            { f32x4 au[2]; \
              _Pragma("unroll") for (int j = 0; j < 2; ++j) au[j] = (f32x4){bflo(U_[j].x), bfhi(U_[j].x), bflo(U_[j].y), bfhi(U_[j].y)}; \
              _Pragma("unroll") for (int ks = 0; ks < 4; ++ks) { \
                  _Pragma("unroll") for (int j = 0; j < 2; ++j) { const bf16x8 bb = *(const LAS bf16x8*)(Sc + ((vt0 + j) * 16 + fr) * 136 + ks * 32 + fq * 8); au[j] = MFMA16(W_[ks], bb, au[j]); } } \
              _Pragma("unroll") for (int j = 0; j < 2; ++j) *(LAS u32x2*)(uT + ((vt0 + j) * 16 + fr) * 72 + lt * 16 + 4 * fq) = pack4(au[j]); } \
            lds_barrier(); \
            { f32x4 ao[2]; \
              _Pragma("unroll") for (int j = 0; j < 2; ++j) ao[j] = (f32x4){0.f, 0.f, 0.f, 0.f}; \
              _Pragma("unroll") for (int ks = 0; ks < 4; ++ks) { \
                  _Pragma("unroll") for (int j = 0; j < 2; ++j) { const bf16x8 a = *(const LAS bf16x8*)(Sc + ((vt0 + j) * 16 + fr) * 136 + ks * 32 + fq * 8); ao[j] = MFMA16(a, Q_[ks], ao[j]); } } \
              _Pragma("unroll") for (int ks2 = 0; ks2 < 2; ++ks2) { \
                  _Pragma("unroll") for (int j = 0; j < 2; ++j) { const bf16x8 a = *(const LAS bf16x8*)(uT + ((vt0 + j) * 16 + fr) * 72 + ks2 * 32 + fq * 8); ao[j] = MFMA16(a, QK_[ks2], ao[j]); } } \
              _Pragma("unroll") for (int j = 0; j < 2; ++j) *(u32x2*)(ORAW + (rowbase + lt * 16 + fr) * 1024 + h * 128 + vh * 64 + (vt0 + j) * 16 + 4 * fq) = pack4(ao[j]); } \
            { _Pragma("unroll") for (int vt = 0; vt < 4; ++vt) accS[vt] *= dec_; \
              _Pragma("unroll") for (int ks2 = 0; ks2 < 2; ++ks2) { \
                  _Pragma("unroll") for (int vt = 0; vt < 4; ++vt) { const bf16x8 bb = *(const LAS bf16x8*)(uT + (vt * 16 + fr) * 72 + ks2 * 32 + fq * 8); accS[vt] = MFMA16(K_[ks2], bb, accS[vt]); } } \
              _Pragma("unroll") for (int vt = 0; vt < 4; ++vt) *(LAS u32x2*)(Sn + (vt * 16 + fr) * 136 + kt * 16 + 4 * fq) = pack4(accS[vt]); } \
            lds_barrier(); \
            cur ^= 1; } while (0)
        SCAN_LOAD(aW, aQ, aQK, aK, aU, adec, slot0);
        if (nchunk > 1) SCAN_LOAD(bW, bQ, bQK, bK, bU, bdec, slot0 + 1);
        for (int cc = 0; cc < nchunk; cc += 3) {
            if (cc + 2 < nchunk) SCAN_LOAD(cW, cQ, cQK, cK, cU, cdec, slot0 + cc + 2);
            SCAN_STEP(aW, aQ, aQK, aK, aU, adec, cc);
            if (cc + 1 < nchunk) {
                if (cc + 3 < nchunk) SCAN_LOAD(aW, aQ, aQK, aK, aU, adec, slot0 + cc + 3);
                SCAN_STEP(bW, bQ, bQK, bK, bU, bdec, cc + 1);
            }
            if (cc + 2 < nchunk) {
                if (cc + 4 < nchunk) SCAN_LOAD(bW, bQ, bQK, bK, bU, bdec, slot0 + cc + 4);
                SCAN_STEP(cW, cQ, cQK, cK, cU, cdec, cc + 2);
            }
        }
#undef SCAN_STEP
#undef SCAN_LOAD
        if (samp || pass == 3) {
            float* d = samp ? p.out + O_SCS + ((size_t)(i * 32 + b) * 8 + h) * 16384 : p.out + O_SCP + ((size_t)(i * 16 + b) * 8 + h) * 16384;
#pragma unroll
            for (int vt = 0; vt < 4; ++vt)
#pragma unroll
                for (int r = 0; r < 4; ++r) d[(kt * 16 + 4 * fq + r) * 128 + vh * 64 + vt * 16 + fr] = accS[vt][r];
        } else {
#pragma unroll
            for (int vt = 0; vt < 4; ++vt) *(f32x4*)(ssave_wr + ((w * 4 + vt) * 64 + lane) * 4) = accS[vt];
        }
    }
}

__device__ void phase_gdn_scan_fh(const Params& p, int i, int pass, LAS unsigned char* lds, int wave_s) {
    const int tid = tid_fresh(wave_s), w = wave_s, lane = tid & 63, fr = lane & 15, fq = lane >> 4;
    LAS u16* St = (LAS u16*)lds;
    LAS u16* uT = (LAS u16*)(lds + 69632);
    LAS float* rs = (LAS float*)(lds + 88064);
    u16* YM = (u16*)(p.ws + WS_H); const u16* P = (const u16*)(p.ws + WS_P);
    const int nitems = pass == 0 ? 384 : 128;
    const int kt = w, lt = w >> 1, vt0 = (w & 1) * 4;
    for (int it = blockIdx.x; it < nitems; it += gridDim.x) {
        const bool samp = it >= 128; const int chain = samp ? it - 128 : it, b = chain >> 3, h = chain & 7;
        const int nchunk = samp ? 1 : 8, slot0 = samp ? 1024 + chain : chain * 8;
        const long rowbase0 = samp ? MP + (long)b * 64 : (long)b * 2048 + pass * 512;
        const float* ssave_rd = (const float*)(p.ws + WS_SS + (size_t)((pass & 1) * 128 + chain) * 65536);
        float* ssave_wr = (float*)(p.ws + WS_SS + (size_t)(((pass + 1) & 1) * 128 + chain) * 65536);
        f32x4 accS[8];
        if (samp) { const float* s0 = p.in[6] + ((size_t)(i * 32 + b) * 8 + h) * 16384;
#pragma unroll
            for (int vt = 0; vt < 8; ++vt)
#pragma unroll
                for (int r = 0; r < 4; ++r) accS[vt][r] = s0[(kt * 16 + 4 * fq + r) * 128 + vt * 16 + fr]; }
        else if (pass == 0) {
#pragma unroll
            for (int vt = 0; vt < 8; ++vt) accS[vt] = (f32x4){0.f, 0.f, 0.f, 0.f}; }
        else {
#pragma unroll
            for (int vt = 0; vt < 8; ++vt) accS[vt] = *(const f32x4*)(ssave_rd + ((w * 8 + vt) * 64 + lane) * 4); }
        lds_barrier();
#pragma unroll
        for (int vt = 0; vt < 8; ++vt) *(LAS u32x2*)(St + (vt * 16 + fr) * 136 + kt * 16 + 4 * fq) = pack4(accS[vt]);
        lds_barrier();
        int cur = 0;
        for (int cc = 0; cc < nchunk; ++cc) {
            const unsigned char* sl = p.ws + WS_G + (size_t)(slot0 + cc) * SLOT;
            const long rowbase = rowbase0 + cc * 64;
            bf16x8 cW[4], cQ[4], cQK[2], cK[2]; u32x2 cU[4], zz[4];
#pragma unroll
            for (int ks = 0; ks < 4; ++ks) { cW[ks] = *(const bf16x8*)((const u16*)sl + (lt * 16 + fr) * 128 + ks * 32 + fq * 8); cQ[ks] = *(const bf16x8*)((const u16*)(sl + 32768) + (lt * 16 + fr) * 128 + ks * 32 + fq * 8); }
#pragma unroll
            for (int ks2 = 0; ks2 < 2; ++ks2) { cQK[ks2] = *(const bf16x8*)((const u16*)(sl + 65536) + (lt * 16 + fr) * 64 + ks2 * 32 + fq * 8); cK[ks2] = *(const bf16x8*)((const u16*)(sl + 49152) + (kt * 16 + fr) * 64 + ks2 * 32 + fq * 8); }
#pragma unroll
            for (int j = 0; j < 4; ++j) { cU[j] = *(const u32x2*)((const u16*)(sl + 16384) + ((vt0 + j) * 16 + fr) * 64 + lt * 16 + 4 * fq);
                zz[j] = *(const u32x2*)(P + (rowbase + lt * 16 + fr) * 4096 + 3072 + h * 128 + (vt0 + j) * 16 + 4 * fq); }
            const float cdec = *(const float*)(sl + 73728);
            LAS u16* Sc = St + cur * 128 * 136; LAS u16* Sn = St + (cur ^ 1) * 128 * 136;
            { f32x4 au[4];
#pragma unroll
              for (int j = 0; j < 4; ++j) au[j] = (f32x4){bflo(cU[j].x), bfhi(cU[j].x), bflo(cU[j].y), bfhi(cU[j].y)};
#pragma unroll
              for (int ks = 0; ks < 4; ++ks) {
#pragma unroll
                  for (int j = 0; j < 4; ++j) { const bf16x8 bb = *(const LAS bf16x8*)(Sc + ((vt0 + j) * 16 + fr) * 136 + ks * 32 + fq * 8); au[j] = MFMA16(cW[ks], bb, au[j]); } }
#pragma unroll
              for (int j = 0; j < 4; ++j) *(LAS u32x2*)(uT + ((vt0 + j) * 16 + fr) * 72 + lt * 16 + 4 * fq) = pack4(au[j]); }
            lds_barrier();
            f32x4 ao[4];
#pragma unroll
            for (int j = 0; j < 4; ++j) ao[j] = (f32x4){0.f, 0.f, 0.f, 0.f};
#pragma unroll
            for (int ks = 0; ks < 4; ++ks) {
#pragma unroll
                for (int j = 0; j < 4; ++j) { const bf16x8 a = *(const LAS bf16x8*)(Sc + ((vt0 + j) * 16 + fr) * 136 + ks * 32 + fq * 8); ao[j] = MFMA16(a, cQ[ks], ao[j]); } }
#pragma unroll
            for (int ks2 = 0; ks2 < 2; ++ks2) {
#pragma unroll
                for (int j = 0; j < 4; ++j) { const bf16x8 a = *(const LAS bf16x8*)(uT + ((vt0 + j) * 16 + fr) * 72 + ks2 * 32 + fq * 8); ao[j] = MFMA16(a, cQK[ks2], ao[j]); } }
            { float ss = 0.f;
#pragma unroll
              for (int j = 0; j < 4; ++j) ss += ao[j][0] * ao[j][0] + ao[j][1] * ao[j][1] + ao[j][2] * ao[j][2] + ao[j][3] * ao[j][3];
              ss += shx(ss, 16, lane); ss += shx(ss, 32, lane);
              if (fq == 0) rs[(lt * 16 + fr) * 2 + (w & 1)] = ss; }
            {
#pragma unroll
              for (int vt = 0; vt < 8; ++vt) accS[vt] *= cdec;
#pragma unroll
              for (int ks2 = 0; ks2 < 2; ++ks2) {
#pragma unroll
                  for (int vt = 0; vt < 8; ++vt) { const bf16x8 bb = *(const LAS bf16x8*)(uT + (vt * 16 + fr) * 72 + ks2 * 32 + fq * 8); accS[vt] = MFMA16(cK[ks2], bb, accS[vt]); } }
#pragma unroll
              for (int vt = 0; vt < 8; ++vt) *(LAS u32x2*)(Sn + (vt * 16 + fr) * 136 + kt * 16 + 4 * fq) = pack4(accS[vt]); }
            lds_barrier();
            { const float tot = rs[(lt * 16 + fr) * 2] + rs[(lt * 16 + fr) * 2 + 1]; const float rstd = rsqrtf(tot * (1.0f / 128.0f) + 1e-6f);
#pragma unroll
              for (int j = 0; j < 4; ++j) { const f32x4 onj = *(const f32x4*)(p.in[17] + i * 128 + (vt0 + j) * 16 + 4 * fq); f32x4 y; y[0] = ao[j][0] * rstd * onj[0] * silu_f(bflo(zz[j].x)); y[1] = ao[j][1] * rstd * onj[1] * silu_f(bfhi(zz[j].x));
                  y[2] = ao[j][2] * rstd * onj[2] * silu_f(bflo(zz[j].y)); y[3] = ao[j][3] * rstd * onj[3] * silu_f(bfhi(zz[j].y));
                  *(u32x2*)(YM + (rowbase + lt * 16 + fr) * 1024 + h * 128 + (vt0 + j) * 16 + 4 * fq) = pack4(y); } }
            cur ^= 1;
        }
        if (samp || pass == 3) {
            float* d = samp ? p.out + O_SCS + ((size_t)(i * 32 + b) * 8 + h) * 16384 : p.out + O_SCP + ((size_t)(i * 16 + b) * 8 + h) * 16384;
#pragma unroll
            for (int vt = 0; vt < 8; ++vt)
#pragma unroll
                for (int r = 0; r < 4; ++r) d[(kt * 16 + 4 * fq + r) * 128 + vt * 16 + fr] = accS[vt][r];
        } else {
#pragma unroll
            for (int vt = 0; vt < 8; ++vt) *(f32x4*)(ssave_wr + ((w * 8 + vt) * 64 + lane) * 4) = accS[vt];
        }
    }
}

__device__ void phase_gdn_gate(const Params& p, int i, int wave_s) {
    const int tidn = tid_fresh(wave_s); const int lane = tidn & 63, wv = tidn >> 6;
    u16* H = (u16*)(p.ws + WS_H); const u16* P = (const u16*)(p.ws + WS_P); const float* onorm = p.in[17] + i * 128;
    for (int row = blockIdx.x * 8 + wv; row < MT; row += gridDim.x * 8) {
#pragma unroll
        for (int s = 0; s < 4; ++s) {
            const u32x2 ow = *(const u32x2*)(H + (size_t)row * 1024 + s * 256 + lane * 4); const u32x2 zw = *(const u32x2*)(P + (size_t)row * 4096 + 3072 + s * 256 + lane * 4);
            f32x4 o = (f32x4){bflo(ow.x), bfhi(ow.x), bflo(ow.y), bfhi(ow.y)}; const f32x4 z = (f32x4){bflo(zw.x), bfhi(zw.x), bflo(zw.y), bfhi(zw.y)};
            float ss = o[0] * o[0] + o[1] * o[1] + o[2] * o[2] + o[3] * o[3];
            ss += shx(ss, 1, lane); ss += shx(ss, 2, lane); ss += shx(ss, 4, lane); ss += shx(ss, 8, lane); ss += shx(ss, 16, lane);
            const float rstd = rsqrtf(ss * (1.0f / 128.0f) + 1e-6f);
            const f32x4 g = *(const f32x4*)(onorm + ((lane * 4) & 127));
            f32x4 y;
#pragma unroll
            for (int e = 0; e < 4; ++e) y[e] = o[e] * rstd * g[e] * silu_f(z[e]);
            *(u32x2*)(H + (size_t)row * 1024 + s * 256 + lane * 4) = pack4(y);
        }
    }
}

__device__ void dbg_dump_u16(const Params& p, const u16* src, size_t n, size_t stride, size_t out_off, int wave_s) {
    const int t = tid_fresh(wave_s);
#pragma unroll 1
    for (size_t e = (size_t)blockIdx.x * 512 + t; e < n; e += (size_t)gridDim.x * 512) p.out[out_off + e] = (float)src[e * stride];
}
__device__ void dbg_dump_f32(const Params& p, const float* src, size_t n, size_t out_off, int wave_s) {
    const int t = tid_fresh(wave_s);
#pragma unroll 1
    for (size_t e = (size_t)blockIdx.x * 512 + t; e < n; e += (size_t)gridDim.x * 512) p.out[out_off + e] = src[e];
}
__device__ __forceinline__ void gsync(cg::grid_group& g, int wave_s) {
    asm volatile("s_waitcnt vmcnt(0) lgkmcnt(0)" ::: "memory");
    __syncthreads();
    g.sync();
    if (wave_s == 0) { const int l = tid_fresh(0);
        if (l == 0) { __builtin_amdgcn_fence(__ATOMIC_ACQUIRE, "agent"); asm volatile("s_waitcnt vmcnt(0)" ::: "memory"); } }
    __syncthreads();
}
typedef const __attribute__((address_space(4))) Params* KParamsPtr;
__device__ __forceinline__ Params kargs() {
#if defined(__HIP_DEVICE_COMPILE__)
    unsigned long k = (unsigned long)__builtin_amdgcn_kernarg_segment_ptr(); asm volatile("" : "+s"(k)); return *(KParamsPtr)k;
#else
    return Params{};
#endif
}
#define XB_TMO      128
#define XB_XCNT(j)  (256  + 64 * (j))
#define XB_XSUB(j)  (1280 + 64 * (j))
#define XB_XGEN(j)  (2304 + 64 * (j))
#define XB_TOP      3328
#define XB_TOPGEN   3392
#define XB_WORDS    3456
#define XB_SPIN_CAP (1u << 22)
__device__ __forceinline__ unsigned xb_ld(unsigned* p)              { return __hip_atomic_load(p, __ATOMIC_RELAXED, __HIP_MEMORY_SCOPE_AGENT); }
__device__ __forceinline__ unsigned xb_add(unsigned* p, unsigned v) { return __hip_atomic_fetch_add(p, v, __ATOMIC_RELAXED, __HIP_MEMORY_SCOPE_AGENT); }
__device__ __forceinline__ unsigned xb_xcc_id() { return (unsigned)__builtin_amdgcn_s_getreg((3 << 11) | 20) & 0xFu; }
#define XB_SPIN(cond, bar) do { unsigned _sp = 0; while (cond) { __builtin_amdgcn_s_sleep(1); \
    if ((++_sp & 255u) == 0u) { if (xb_ld(&(bar)[XB_TMO])) break; if (_sp > XB_SPIN_CAP) { atomicAdd(&(bar)[XB_TMO], 1u); break; } } } } while (0)
__device__ __forceinline__ void xb_complete(unsigned* bar, unsigned x, unsigned G, unsigned& nloc, unsigned& nx) {
    unsigned sum, cnt, mine, sp = 0u;
    for (;;) {
        sum = 0u; cnt = 0u; mine = 0u;
#pragma unroll
        for (unsigned j = 0; j < 16; ++j) { const unsigned c = xb_ld(&bar[XB_XCNT(j)]); sum += c; cnt += (c > 0u) ? 1u : 0u; mine = (j == x) ? c : mine; }
        if (sum == G) break;
        __builtin_amdgcn_s_sleep(1);
        if ((++sp & 255u) == 0u) { if (xb_ld(&bar[XB_TMO])) break; if (sp > XB_SPIN_CAP) { atomicAdd(&bar[XB_TMO], 1u); break; } }
    }
    nloc = mine > 0u ? mine : 1u; nx = cnt > 0u ? cnt : 1u;
}
__device__ __forceinline__ void gbar(unsigned* bar, volatile LAS unsigned* st, int wave_s) {
    asm volatile("s_waitcnt vmcnt(0) lgkmcnt(0)" ::: "memory");
    __syncthreads();
    if (wave_s == 0) { const int l0 = tid_fresh(0);
      if (l0 == 0) {
        const unsigned x = xb_xcc_id();
        unsigned nloc = st[0], nx = st[1];
        if (nloc == 0u) { xb_complete(bar, x, gridDim.x, nloc, nx); st[0] = nloc; st[1] = nx; }
        const unsigned old = xb_add(&bar[XB_XSUB(x)], 1u);
        const unsigned gen = old / nloc;
        if (old + 1u == (gen + 1u) * nloc) {
            __builtin_amdgcn_fence(__ATOMIC_RELEASE, "agent");
            asm volatile("s_waitcnt vmcnt(0)" ::: "memory");
            const unsigned og = xb_add(&bar[XB_TOP], 1u);
            const unsigned tg = og / nx;
            if (og + 1u == (tg + 1u) * nx) xb_add(&bar[XB_TOPGEN], 1u);
            else XB_SPIN(xb_ld(&bar[XB_TOPGEN]) == tg, bar);
            __builtin_amdgcn_fence(__ATOMIC_ACQUIRE, "agent");
            xb_add(&bar[XB_XGEN(x)], 1u);
            asm volatile("s_waitcnt vmcnt(0)" ::: "memory");
        } else {
            XB_SPIN(xb_ld(&bar[XB_XGEN(x)]) == gen, bar);
            __builtin_amdgcn_fence(__ATOMIC_ACQUIRE, "agent");
            asm volatile("s_waitcnt vmcnt(0)" ::: "memory");
        }
      } }
    __syncthreads();
}
__device__ __forceinline__ bool gemm_idle_rank(int nwg, int G, int c, int& rank, int& count) { const int rem = nwg % G; if (rem == 0) { rank = c; count = G; return true; } rank = c - rem; count = G - rem; return c >= rem; }
__global__ void __launch_bounds__(512) mega_fwd(Params p_unused) {
    extern __shared__ __attribute__((aligned(16))) unsigned char smem[];
    LAS unsigned char* lds = (LAS unsigned char*)smem;
    cg::grid_group grid = cg::this_grid();
    const int G = gridDim.x, cb = blockIdx.x;
    const int wave_s = wave_index();
    unsigned* bar; { const Params p = kargs(); bar = (unsigned*)(p.ws + WS_BAR); }
    volatile LAS unsigned* xst = (volatile LAS unsigned*)(lds + 154112);
    { const int t0 = tid_fresh(wave_s); if (t0 == 0) { xst[0] = 0u; xst[1] = 0u; }
      if (cb == 0) for (int w = t0; w < XB_WORDS; w += 512) __hip_atomic_store(bar + w, 0u, __ATOMIC_RELAXED, __HIP_MEMORY_SCOPE_AGENT); }

    phase_prep_weights(kargs(), lds, wave_s, 0, 0, cb, G);
    phase_prep_cache(kargs(), 0, lds, wave_s, cb, G);
    { const Params p = kargs(); phase_norm(p, true, nullptr, nullptr, p.in[7], 0, wave_s); }
    gsync(grid, wave_s);
    if (wave_s == 0 && tid_fresh(0) == 0) (void)xb_add(&bar[XB_XCNT(xb_xcc_id())], 1u);
#pragma unroll 1
    for (int layer = 0; layer < 4; ++layer) {
        const int i = layer >> 1;
        if ((layer & 1) == 0) {
            { const Params p = kargs(); int cbf = cb; asm volatile("" : "+s"(cbf)); pg8::OrderEven S; S.so.init(MT, 3584, G, cbf, p.ws + WS_H, p.ws + WS_WIE + (size_t)i * 4096 * 1024 * 2); S.Wv = (const char*)(p.ws + WS_WIE + (size_t)i * 4096 * 1024 * 2 + (size_t)3584 * 1024 * 2);
              EpiInEven E{(u16*)(p.ws + WS_P), (u16*)(p.ws + WS_G + G_VT), (u16*)(p.ws + WS_G + G_KF), (u16*)(p.ws + WS_G + G_VTS), p.out, i};
              pg8::gemm_phase(lds, S, E, wave_s); if (DUP == 1) { __syncthreads(); pg8::gemm_phase(lds, S, E, wave_s); } }
            gbar(bar, xst, wave_s); if (DUP == 9) gbar(bar, xst, wave_s);
            phase_attn(kargs(), i, lds, wave_s);
            if (DUP == 2) { __syncthreads(); phase_attn(kargs(), i, lds, wave_s); }
            gbar(bar, xst, wave_s); if (DUP == 9) gbar(bar, xst, wave_s);
            { const Params p = kargs(); int cbf = cb; asm volatile("" : "+s"(cbf)); pg8::StaticOrder S; S.init(MT, 1024, G, cbf, p.ws + WS_H, p.ws + WS_WOE + (size_t)i * 1024 * 1024 * 2); EpiOut E{(u16*)(p.ws + WS_P)}; pg8::gemm_phase(lds, S, E, wave_s); }
            { int rk, cnt; if (gemm_idle_rank(544, G, cb, rk, cnt)) phase_prep_weights(kargs(), lds, wave_s, 1, i, rk, cnt); }
            gbar(bar, xst, wave_s); if (DUP == 9) gbar(bar, xst, wave_s);
        } else {
            { const Params p = kargs(); int cbf = cb; asm volatile("" : "+s"(cbf)); pg8::StaticOrder S; S.init(MT, 4096, G, cbf, p.ws + WS_H, p.ws + WS_WIO + (size_t)i * 4352 * 1024 * 2); EpiInOdd E{(u16*)(p.ws + WS_P), (float*)(p.ws + WS_GATE)}; pg8::gemm_phase(lds, S, E, wave_s); if (DUP == 4) { __syncthreads(); pg8::gemm_phase(lds, S, E, wave_s); } }
            { int rk, cnt; if (gemm_idle_rank(2176, G, cb, rk, cnt)) { phase_gate_logits(kargs(), i, wave_s, rk, cnt); if (layer == 1) phase_prep_weights(kargs(), lds, wave_s, 0, 1, rk, cnt); } }
            gbar(bar, xst, wave_s); if (DUP == 9) gbar(bar, xst, wave_s);
            if (DBG_STOP == 10) { const Params p = kargs(); dbg_dump_u16(kargs(), (const u16*)(p.ws + WS_P), (size_t)47000000, 3, 0, wave_s); dbg_dump_f32(kargs(), (const float*)(p.ws + WS_GATE), (size_t)MT * 16, 48000000, wave_s); return; }
#pragma unroll 1
            for (int pass = 0; pass < 4; ++pass) {
                phase_gdn_pre(kargs(), i, pass, lds, wave_s);
                if (DUP == 5) { __syncthreads(); phase_gdn_pre(kargs(), i, pass, lds, wave_s); }
                if (DUP == 11) { __syncthreads(); phase_gdn_pre(kargs(), i, pass, lds, wave_s, true); }
                gbar(bar, xst, wave_s); if (DUP == 9) gbar(bar, xst, wave_s);
                if (DBG_STOP == 11) { const Params p = kargs(); dbg_dump_u16(kargs(), (const u16*)(p.ws + WS_G), (size_t)1280 * SLOT / 2, 1, 0, wave_s); return; }
                if (SCAN_FH) phase_gdn_scan_fh(kargs(), i, pass, lds, wave_s); else phase_gdn_scan(kargs(), i, pass, lds, wave_s);
                if (DUP == 6) { __syncthreads(); phase_gdn_scan(kargs(), i, pass, lds, wave_s); }
                gbar(bar, xst, wave_s); if (DUP == 9) gbar(bar, xst, wave_s);
                if (DBG_STOP == 12) { const Params p = kargs(); dbg_dump_u16(kargs(), (const u16*)(p.ws + WS_H), (size_t)MT * 1024, 1, 0, wave_s); dbg_dump_f32(kargs(), (const float*)(p.ws + WS_SS), (size_t)256 * 8192, 40000000, wave_s); return; }
                if (DBG_STOP == 13) { const Params p = kargs(); dbg_dump_f32(kargs(), (const float*)(p.ws + WS_SS), (size_t)256 * 8192, 40000000, wave_s); return; }
            }
            if (!SCAN_FH) { phase_gdn_gate(kargs(), i, wave_s);
            gbar(bar, xst, wave_s); } if (DUP == 9) gbar(bar, xst, wave_s);
            { const Params p = kargs(); int cbf = cb; asm volatile("" : "+s"(cbf)); pg8::StaticOrder S; S.init(MT, 1024, G, cbf, p.ws + WS_H, p.ws + WS_WOO + (size_t)i * 1024 * 1024 * 2); EpiOut E{(u16*)(p.ws + WS_P)}; pg8::gemm_phase(lds, S, E, wave_s); }
            if (layer == 1) { int rk, cnt; if (gemm_idle_rank(544, G, cb, rk, cnt)) phase_prep_cache(kargs(), 1, lds, wave_s, rk, cnt); }
            gbar(bar, xst, wave_s); if (DUP == 9) gbar(bar, xst, wave_s);
        }
        { const Params p = kargs(); phase_norm(p, layer == 0, (const u16*)(p.ws + WS_P), p.in[8] + layer * 1024, layer < 3 ? p.in[7] + (layer + 1) * 1024 : nullptr, layer < 3 ? 1 : 2, wave_s); }
        if (layer == DBG_STOP) return;
        if (layer < 3) gbar(bar, xst, wave_s); if (DUP == 9) gbar(bar, xst, wave_s);
    }
}

extern "C" void kernel_launch(void* const* d_in, const int* in_sizes, int n_in, void* d_out, int out_size, void* d_ws, size_t ws_size, hipStream_t stream) {
    static int grid = 0;
    if (grid == 0) {
        if (n_in != 19 || ws_size < WS_END) { fprintf(stderr, "kernel_launch: unexpected n_in %d or workspace %zu < %zu\n", n_in, ws_size, (size_t)WS_END); grid = -1; return; }
        int dev = 0, cus = 0, per_cu = 0;
        if (hipGetDevice(&dev) != hipSuccess || hipDeviceGetAttribute(&cus, hipDeviceAttributeMultiprocessorCount, dev) != hipSuccess) { grid = -1; return; }
        if (hipFuncSetAttribute((const void*)mega_fwd, hipFuncAttributeMaxDynamicSharedMemorySize, LDS_BYTES) != hipSuccess) { fprintf(stderr, "kernel_launch: hipFuncSetAttribute failed\n"); grid = -1; return; }
        if (hipOccupancyMaxActiveBlocksPerMultiprocessor(&per_cu, (const void*)mega_fwd, 512, LDS_BYTES) != hipSuccess || per_cu < 1) { fprintf(stderr, "kernel_launch: occupancy query says %d blocks/CU\n", per_cu); grid = -1; return; }
        grid = cus;
    }
    if (grid < 0) return;
    Params p{};
    for (int k = 0; k < 19; ++k) p.in[k] = (const float*)d_in[k];
    p.out = (float*)d_out; p.ws = (unsigned char*)d_ws;
    void* args[] = {&p};
    hipError_t e = hipLaunchCooperativeKernel((const void*)mega_fwd, dim3(grid), dim3(512), args, LDS_BYTES, stream);
    if (e != hipSuccess) fprintf(stderr, "cooperative launch failed: %s (grid %d)\n", hipGetErrorString(e), grid);
}
```
